# Optimizing an MI355X kernel written in HIP

```python
import math
import jax, jax.numpy as jnp
from jax import lax
import numpy as np

D_MODEL = 1024
BATCH = 1
SEQ = 16384
DEPTH = 4

CHUNK = 64
N_A_LAYERS = DEPTH // 2
N_B_LAYERS = DEPTH - N_A_LAYERS
SSM_GROUP = 16
SSM_GROUPS = D_MODEL // SSM_GROUP
SSM_STATE = 64
DT_MIN = 1e-3
DT_MAX = 1e-1
N_HEADS = 16
HEAD_DIM = D_MODEL // N_HEADS
Q_BLOCK = 2 * CHUNK
D_FF = ((8 * D_MODEL + 3 * 256 - 1) // (3 * 256)) * 256
EPS = 1e-6

kernel_name = "yoco_s5_stickbreaking_trunk"


def rms_norm(x, g):
    xf = x.astype(jnp.float32)
    y = xf * lax.rsqrt(jnp.mean(xf * xf, axis=-1, keepdims=True) + EPS)
    return (y * g.astype(jnp.float32)).astype(x.dtype)


def swiglu(x, w_in, w_out):
    gate, up = jnp.split(x @ w_in, 2, axis=-1)
    return (jax.nn.silu(gate) * up) @ w_out


def s5_mixer(u, log_dt, a_re, a_im, b_re, b_im, c_re, c_im, d_skip, w_glu, b_glu):
    f32 = jnp.float32
    bsz, seq_len, _ = u.shape
    uf = u.astype(f32).reshape(bsz, seq_len, SSM_GROUPS, SSM_GROUP)
    lam = lax.complex(a_re.astype(f32), a_im.astype(f32))
    dt = jnp.exp(log_dt.astype(f32))[:, None]
    lam_bar = jnp.exp(lam * dt)
    b_mat = lax.complex(b_re.astype(f32), b_im.astype(f32))
    b_bar = ((lam_bar - 1.0) / lam)[..., None] * b_mat
    bu = jnp.einsum('blgc,gpc->blgp', uf.astype(jnp.complex64), b_bar)
    a_elems = jnp.broadcast_to(lam_bar, bu.shape)

    def combine(left, right):
        a_l, b_l = left
        a_r, b_r = right
        return a_r * a_l, a_r * b_l + b_r

    _, states = lax.associative_scan(combine, (a_elems, bu), axis=1)
    c_mat = lax.complex(c_re.astype(f32), c_im.astype(f32))
    y = jnp.einsum('blgp,gcp->blgc', states, c_mat).real
    y = y + d_skip.astype(f32) * uf
    y = jax.nn.gelu(y.reshape(bsz, seq_len, D_MODEL)).astype(u.dtype)
    val, gate = jnp.split(y @ w_glu + b_glu, 2, axis=-1)
    return val * jax.nn.sigmoid(gate)


def stick_breaking_attention(q, k, v):
    bsz, n_h, seq_len, dh = q.shape
    nblk = seq_len // Q_BLOCK

    def to_blocks(a):
        return a.reshape(bsz, n_h, nblk, Q_BLOCK, dh).transpose(2, 0, 1, 3, 4)

    qb = to_blocks(q * (dh ** -0.5))
    kb = to_blocks(k)
    vb = to_blocks(v)
    pos = jnp.arange(Q_BLOCK)
    diag_mask = pos[:, None] > pos[None, :]

    def one_query_block(args):
        i, q_i = args

        def body(step, carry):
            out, log_rest = carry
            j = i - step
            k_j = kb[j]
            v_j = vb[j]
            z = jnp.einsum('bhqd,bhkd->bhqk', q_i, k_j)
            mask = jnp.where(j == i, diag_mask, True)
            log_beta = jax.nn.log_sigmoid(z)
            log_1m = jnp.where(mask, jax.nn.log_sigmoid(-z), 0.0)
            later = lax.cumsum(log_1m, axis=3, reverse=True) - log_1m
            w = jnp.where(mask, jnp.exp(log_beta + later + log_rest[..., None]), 0.0)
            out = out + jnp.einsum('bhqk,bhkd->bhqd', w, v_j)
            log_rest = log_rest + jnp.sum(log_1m, axis=3)
            return out, log_rest

        init = (jnp.zeros_like(q_i), jnp.zeros(q_i.shape[:-1], jnp.float32))
        out, _ = lax.fori_loop(0, i + 1, body, init)
        return out

    out = lax.map(one_query_block, (jnp.arange(nblk), qb))
    return out.transpose(1, 2, 0, 3, 4).reshape(bsz, n_h, seq_len, dh)


def split_heads(t):
    bsz, seq_len, _ = t.shape
    return t.reshape(bsz, seq_len, N_HEADS, HEAD_DIM).transpose(0, 2, 1, 3).astype(jnp.float32)


def setup_inputs(seed: int = 0) -> dict:
    key = jax.random.key(seed)
    ks = jax.random.split(key, 24)
    f32 = jnp.float32

    def nrm(k, shape, scale):
        return jax.random.normal(k, shape, f32) * scale

    def gains(k, shape):
        return 1.0 + 0.02 * jax.random.normal(k, shape, f32)

    n_idx = jnp.arange(SSM_STATE, dtype=f32)
    a_im0 = jnp.broadcast_to(math.pi * n_idx, (N_A_LAYERS, SSM_GROUPS, SSM_STATE))
    return {
        'x': jax.random.normal(ks[0], (BATCH, SEQ, D_MODEL), f32),
        'norm_mix_pre': gains(ks[1], (DEPTH, D_MODEL)),
        'norm_mix_post': gains(ks[2], (DEPTH, D_MODEL)),
        'norm_ffn_pre': gains(ks[3], (DEPTH, D_MODEL)),
        'norm_ffn_post': gains(ks[4], (DEPTH, D_MODEL)),
        'w_ffn_in': nrm(ks[5], (DEPTH, D_MODEL, 2 * D_FF), D_MODEL ** -0.5),
        'w_ffn_out': nrm(ks[6], (DEPTH, D_FF, D_MODEL), D_FF ** -0.5),
        's5_log_dt': jax.random.uniform(ks[7], (N_A_LAYERS, SSM_GROUPS), f32,
                                        math.log(DT_MIN), math.log(DT_MAX)),
        's5_a_re': -0.5 + 0.01 * jax.random.normal(ks[8], (N_A_LAYERS, SSM_GROUPS, SSM_STATE), f32),
        's5_a_im': a_im0 + 0.01 * jax.random.normal(ks[9], (N_A_LAYERS, SSM_GROUPS, SSM_STATE), f32),
        's5_b_re': nrm(ks[10], (N_A_LAYERS, SSM_GROUPS, SSM_STATE, SSM_GROUP), (2 * SSM_GROUP) ** -0.5),
        's5_b_im': nrm(ks[11], (N_A_LAYERS, SSM_GROUPS, SSM_STATE, SSM_GROUP), (2 * SSM_GROUP) ** -0.5),
        's5_c_re': nrm(ks[12], (N_A_LAYERS, SSM_GROUPS, SSM_GROUP, SSM_STATE), (2 * SSM_STATE) ** -0.5),
        's5_c_im': nrm(ks[13], (N_A_LAYERS, SSM_GROUPS, SSM_GROUP, SSM_STATE), (2 * SSM_STATE) ** -0.5),
        's5_d': nrm(ks[14], (N_A_LAYERS, SSM_GROUPS, SSM_GROUP), 1.0),
        's5_w_glu': nrm(ks[15], (N_A_LAYERS, D_MODEL, 2 * D_MODEL), D_MODEL ** -0.5),
        's5_b_glu': nrm(ks[16], (N_A_LAYERS, 2 * D_MODEL), 0.01),
        'kv_norm': gains(ks[17], (D_MODEL,)),
        'w_k': nrm(ks[18], (D_MODEL, D_MODEL), D_MODEL ** -0.5),
        'w_v': nrm(ks[19], (D_MODEL, D_MODEL), D_MODEL ** -0.5),
        'w_q': nrm(ks[20], (N_B_LAYERS, D_MODEL, D_MODEL), D_MODEL ** -0.5),
        'w_o': nrm(ks[21], (N_B_LAYERS, D_MODEL, D_MODEL), D_MODEL ** -0.5),
    }


def reference(x, norm_mix_pre, norm_mix_post, norm_ffn_pre, norm_ffn_post, w_ffn_in, w_ffn_out,
              s5_log_dt, s5_a_re, s5_a_im, s5_b_re, s5_b_im, s5_c_re, s5_c_im, s5_d,
              s5_w_glu, s5_b_glu, kv_norm, w_k, w_v, w_q, w_o):
    bsz, seq_len, _ = x.shape
    h = x
    k_shared = None
    v_shared = None
    for layer in range(DEPTH):
        u = rms_norm(h, norm_mix_pre[layer])
        if layer < N_A_LAYERS:
            mix = s5_mixer(u, s5_log_dt[layer], s5_a_re[layer], s5_a_im[layer],
                           s5_b_re[layer], s5_b_im[layer], s5_c_re[layer], s5_c_im[layer],
                           s5_d[layer], s5_w_glu[layer], s5_b_glu[layer])
        else:
            if layer == N_A_LAYERS:
                hk = rms_norm(h, kv_norm)
                k_shared = split_heads(hk @ w_k)
                v_shared = split_heads(hk @ w_v)
            b = layer - N_A_LAYERS
            q = split_heads(u @ w_q[b])
            o = stick_breaking_attention(q, k_shared, v_shared)
            o = o.transpose(0, 2, 1, 3).reshape(bsz, seq_len, D_MODEL).astype(h.dtype)
            mix = o @ w_o[b]
        h = h + rms_norm(mix, norm_mix_post[layer])
        f = swiglu(rms_norm(h, norm_ffn_pre[layer]), w_ffn_in[layer], w_ffn_out[layer])
        h = h + rms_norm(f, norm_ffn_post[layer])
    return h
```

```cpp
#include <hip/hip_runtime.h>
#include <hip/hip_cooperative_groups.h>
#include <cstdio>
#include <cstdint>
namespace cg = cooperative_groups;

#ifndef DIAG
#define DIAG 0
#endif
#ifndef DIAG_NOEXIT
#define DIAG_NOEXIT 0
#endif
#ifndef DIAG_NIB
#define DIAG_NIB 0
#endif
#ifndef MK_ONE_LAUNCH
#define MK_ONE_LAUNCH 1
#endif

#define LAS __attribute__((address_space(3)))
typedef unsigned short bf16_t;
typedef short bf16x8 __attribute__((ext_vector_type(8)));
typedef short s16x4 __attribute__((ext_vector_type(4)));
typedef float f32x4 __attribute__((ext_vector_type(4)));
typedef float f32x2 __attribute__((ext_vector_type(2)));
typedef unsigned u32x4 __attribute__((ext_vector_type(4)));
typedef unsigned u32x2 __attribute__((ext_vector_type(2)));

constexpr int L = 16384, D = 1024, DFF = 2816, NG = 64, NCH = 1024, AK = 384;
constexpr float EPS = 1e-6f;
constexpr size_t MiB = 1u << 20;
constexpr size_t WS_WIN = 1 * MiB, WS_WOUT = 45 * MiB, WS_WGLU = 67 * MiB, WS_WK = 75 * MiB, WS_WV = 77 * MiB, WS_WQ = 79 * MiB, WS_WO = 83 * MiB;
constexpr size_t WS_BT3 = 87 * MiB, WS_W1T = 111 * MiB, WS_SC = 120 * MiB, WS_AEXT = 121 * MiB, WS_S = 169 * MiB, WS_ACT = 201 * MiB, WS_MIX = 289 * MiB, WS_END = 321 * MiB;
constexpr size_t WS_VT = WS_AEXT, WS_KB = WS_S, WS_Y = WS_ACT, WS_Q = WS_ACT, WS_O = WS_ACT + 32 * MiB, WS_HK = WS_ACT + 56 * MiB;
constexpr int LDS_BYTES = 147456;

__device__ __forceinline__ unsigned cvt_pk_bf16(float lo, float hi) { unsigned r; asm volatile("v_cvt_pk_bf16_f32 %0, %1, %2" : "=v"(r) : "v"(lo), "v"(hi)); return r; }
__device__ __forceinline__ float bf_lo(unsigned w) { return __uint_as_float(w << 16); }
__device__ __forceinline__ float bf_hi(unsigned w) { return __uint_as_float(w & 0xffff0000u); }
__device__ __forceinline__ float wave_sum(float v) {
#pragma unroll
    for (int o = 1; o < 64; o <<= 1) v += __shfl_xor(v, o);
    return v;
}
#define LDS_WAIT() asm volatile("s_waitcnt lgkmcnt(0)" ::: "memory")

namespace pg8 {
constexpr int BM = 256, BK = 64, HALF = 128, HTB = HALF * BK * 2, NXCD = 8, WGM = 8;
__device__ __forceinline__ int lds_byte(int r, int c) { const int st = (r >> 4) * 2 + (c >> 5), rr = r & 15, cc = c & 31, ob = rr * 64 + cc * 2; return st * 1024 + (ob ^ (((ob >> 9) & 1) << 5)); }
__device__ __forceinline__ void stage_rc(int b, int& R, int& C) { const int st = b / 1024, sb = b % 1024, swz = sb ^ (((sb >> 9) & 1) << 5); R = (st >> 1) * 16 + swz / 64; C = (st & 1) * 32 + (swz % 64) / 2; }

struct Unit { int pm, pn, b; };
struct Gemm { const bf16_t* A; const bf16_t* Bt; int M, N, K, lda, ldb, batch; unsigned bsA, bsB; };
struct Order {
    int nM, nN, per, total, G, c;
    __device__ __forceinline__ void init(int M, int N, int batch, int G_, int c_) { nM = M / BM; nN = N / BM; per = nM * nN; total = per * batch; G = G_; c = c_; }
    __device__ __forceinline__ bool next(int i, Unit& u) const {
        const int Lx = i * G + c; if (Lx >= total) return false;
        u.b = Lx / per; int wgid = Lx - u.b * per;
        { const int q = per / NXCD, r = per % NXCD, xcd = wgid % NXCD, off = wgid / NXCD; wgid = (xcd < r ? xcd * (q + 1) : r * (q + 1) + (xcd - r) * q) + off; }
        const int nig = WGM * nN, gid = wgid / nig, fm = gid * WGM, gsz = (nM - fm) < WGM ? (nM - fm) : WGM;
        u.pm = fm + ((wgid % nig) % gsz); u.pn = (wgid % nig) / gsz; return true;
    }
};

struct EpiPlain {
    bf16_t* O; int ldc; float scale;
    __device__ __forceinline__ void operator()(const f32x4 (&acc)[2][2][4][2], const Unit& u, int wr, int wc, int fr, int fq) const {
        const int row0 = u.pm * BM + wr * 64 + fr, col0 = u.pn * BM + wc * 32 + 4 * fq;
#pragma unroll
        for (int ai = 0; ai < 2; ++ai)
#pragma unroll
            for (int m = 0; m < 4; ++m) { bf16_t* rowp = O + (size_t)(row0 + ai * HALF + m * 16) * ldc + col0;
#pragma unroll
                for (int bj = 0; bj < 2; ++bj)
#pragma unroll
                    for (int n = 0; n < 2; ++n) { const f32x4 v = acc[ai][bj][m][n] * scale; u32x2 w; w.x = cvt_pk_bf16(v[0], v[1]); w.y = cvt_pk_bf16(v[2], v[3]); *(u32x2*)(rowp + bj * HALF + n * 16) = w; } }
    }
};
struct EpiSwiGLU {
    bf16_t* O; int ldc;
    __device__ __forceinline__ void operator()(const f32x4 (&acc)[2][2][4][2], const Unit& u, int wr, int wc, int fr, int fq) const {
        const int row0 = u.pm * BM + wr * 64 + fr, col0 = u.pn * HALF + wc * 32 + 4 * fq;
#pragma unroll
        for (int ai = 0; ai < 2; ++ai)
#pragma unroll
            for (int m = 0; m < 4; ++m) { bf16_t* rowp = O + (size_t)(row0 + ai * HALF + m * 16) * ldc + col0;
#pragma unroll
                for (int n = 0; n < 2; ++n) { const f32x4 g = acc[ai][0][m][n], up = acc[ai][1][m][n]; f32x4 v;
#pragma unroll
                    for (int e = 0; e < 4; ++e) v[e] = g[e] * up[e] * __builtin_amdgcn_rcpf(1.0f + __expf(-g[e]));
                    u32x2 w; w.x = cvt_pk_bf16(v[0], v[1]); w.y = cvt_pk_bf16(v[2], v[3]); *(u32x2*)(rowp + n * 16) = w; } }
    }
};
struct EpiGLU {
    bf16_t* O; int ldc; const float* bias; int halfN;
    __device__ __forceinline__ void operator()(const f32x4 (&acc)[2][2][4][2], const Unit& u, int wr, int wc, int fr, int fq) const {
        const int row0 = u.pm * BM + wr * 64 + fr, col0 = u.pn * HALF + wc * 32 + 4 * fq;
        f32x4 bv[2], bg[2];
#pragma unroll
        for (int n = 0; n < 2; ++n) { bv[n] = *(const f32x4*)(bias + col0 + n * 16); bg[n] = *(const f32x4*)(bias + halfN + col0 + n * 16); }
#pragma unroll
        for (int ai = 0; ai < 2; ++ai)
#pragma unroll
            for (int m = 0; m < 4; ++m) { bf16_t* rowp = O + (size_t)(row0 + ai * HALF + m * 16) * ldc + col0;
#pragma unroll
                for (int n = 0; n < 2; ++n) { const f32x4 a = acc[ai][0][m][n] + bv[n], g = acc[ai][1][m][n] + bg[n]; f32x4 v;
#pragma unroll
                    for (int e = 0; e < 4; ++e) v[e] = a[e] * __builtin_amdgcn_rcpf(1.0f + __expf(-g[e]));
                    u32x2 w; w.x = cvt_pk_bf16(v[0], v[1]); w.y = cvt_pk_bf16(v[2], v[3]); *(u32x2*)(rowp + n * 16) = w; } }
    }
};
struct EpiS5State {
    float* S;
    __device__ __forceinline__ void operator()(const f32x4 (&acc)[2][2][4][2], const Unit& u, int wr, int wc, int fr, int fq) const {
        const int row0 = u.pm * BM + wr * 64 + fr, col0 = wc * 32 + 4 * fq;
#pragma unroll
        for (int ai = 0; ai < 2; ++ai)
#pragma unroll
            for (int m = 0; m < 4; ++m) { float* rowp = S + ((size_t)u.b * NCH + row0 + ai * HALF + m * 16) * 128 + col0;
#pragma unroll
                for (int n = 0; n < 2; ++n) *(f32x4*)(rowp + n * 16) = acc[ai][0][m][n]; }
    }
};
struct EpiS5Out {
    const bf16_t* Aext; const float* dskip; bf16_t* Y;
    __device__ __forceinline__ void operator()(const f32x4 (&acc)[2][2][4][2], const Unit& u, int wr, int wc, int fr, int fq) const {
        const int row0 = u.pm * BM + wr * 64 + fr;
        const f32x4 dv = *(const f32x4*)(dskip + u.b * 16 + 4 * fq);
#pragma unroll
        for (int ai = 0; ai < 2; ++ai)
#pragma unroll
            for (int m = 0; m < 4; ++m) { const int row = row0 + ai * HALF + m * 16; const bf16_t* up = Aext + ((size_t)u.b * NCH + row) * AK + wc * 32 + 4 * fq;
#pragma unroll
                for (int bj = 0; bj < 2; ++bj)
#pragma unroll
                    for (int n = 0; n < 2; ++n) { const u32x2 uu = *(const u32x2*)(up + bj * HALF + n * 16); const f32x4 a = acc[ai][bj][m][n];
                        f32x4 v; v[0] = a[0] + dv[0] * bf_lo(uu.x); v[1] = a[1] + dv[1] * bf_hi(uu.x); v[2] = a[2] + dv[2] * bf_lo(uu.y); v[3] = a[3] + dv[3] * bf_hi(uu.y);
#pragma unroll
                        for (int e = 0; e < 4; ++e) { const float x = v[e], t = 1.5957691216057308f * (x + 0.044715f * x * x * x); v[e] = x * __builtin_amdgcn_rcpf(1.0f + __expf(-t)); }
                        const int i = 8 * bj + 2 * wc + n; u32x2 w; w.x = cvt_pk_bf16(v[0], v[1]); w.y = cvt_pk_bf16(v[2], v[3]);
                        *(u32x2*)(Y + (size_t)(row * 16 + i) * D + u.b * 16 + 4 * fq) = w; } }
    }
};

template <class Epi>
__device__ __forceinline__ void gemm_phase(LAS unsigned char* lds, const Gemm g, const Epi& E, int G, int c, int tid) {
    const int wid = __builtin_amdgcn_readfirstlane(tid >> 6), lane = tid & 63, wr = wid >> 2, wc = wid & 3, fr = lane & 15, fq = lane >> 4;
    const int nt = g.K / BK;
    unsigned voffA[2], voffB[2];
#pragma unroll
    for (int i = 0; i < 2; ++i) { int R, C; stage_rc(tid * 16 + i * 8192, R, C); voffA[i] = (unsigned)(R * g.lda + C) * 2u; voffB[i] = (unsigned)(R * g.ldb + C) * 2u; }
    constexpr unsigned kstep = BK * 2;
    const unsigned hA = (unsigned)HALF * g.lda * 2, hB = (unsigned)HALF * g.ldb * 2, tA = 2 * hA, tB = 2 * hB;
    const unsigned ldsw = (unsigned)wid * 1024u;
    const int aoff = lds_byte(wr * 64 + fr, fq * 8), boff = lds_byte(wc * 32 + fr, fq * 8);
#define PG8_SA(b, h) (((b) * 2 + (h)) * HTB)
#define PG8_SB(b, h) ((4 + (b) * 2 + (h)) * HTB)
#define PG8_STAGE(bufoff, gbase, voff) do { _Pragma("unroll") for (int _i = 0; _i < 2; ++_i) \
        __builtin_amdgcn_global_load_lds((const unsigned*)((const char*)(gbase) + (voff)[_i]), (LAS unsigned*)(lds + (bufoff) + ldsw + _i * 8192), 16, 0, 0); } while (0)
#define PG8_LDA(dst, b, h) do { _Pragma("unroll") for (int m = 0; m < 4; ++m) _Pragma("unroll") for (int k = 0; k < 2; ++k) dst[m][k] = *(const LAS bf16x8*)(lds + PG8_SA(b, h) + aoff + m * 2048 + k * 1024); } while (0)
#define PG8_LDB(dst, b, h) do { _Pragma("unroll") for (int n = 0; n < 2; ++n) _Pragma("unroll") for (int k = 0; k < 2; ++k) dst[n][k] = *(const LAS bf16x8*)(lds + PG8_SB(b, h) + boff + n * 2048 + k * 1024); } while (0)
#define PG8_MMA(ai, bj, At, Bt) do { __builtin_amdgcn_s_setprio(1); _Pragma("unroll") for (int m = 0; m < 4; ++m) _Pragma("unroll") for (int n = 0; n < 2; ++n) _Pragma("unroll") for (int k = 0; k < 2; ++k) \
        acc[ai][bj][m][n] = __builtin_amdgcn_mfma_f32_16x16x32_bf16(Bt[n][k], At[m][k], acc[ai][bj][m][n], 0, 0, 0); __builtin_amdgcn_s_setprio(0); } while (0)
#define PG8_WAIT_V(n) asm volatile("s_waitcnt vmcnt(" #n ")" ::: "memory")
#define PG8_WAIT_L(n) asm volatile("s_waitcnt lgkmcnt(" #n ")" ::: "memory")
#define PG8_BAR __builtin_amdgcn_s_barrier()
#define PG8_SCHED __builtin_amdgcn_sched_barrier(0)
    Order S; S.init(g.M, g.N, g.batch, G, c);
    Unit cur, nxt; int ui = 0;
    if (!S.next(0, cur)) return;
    f32x4 acc[2][2][4][2];
#pragma unroll
    for (int a = 0; a < 2; ++a)
#pragma unroll
        for (int b = 0; b < 2; ++b)
#pragma unroll
            for (int m = 0; m < 4; ++m)
#pragma unroll
                for (int n = 0; n < 2; ++n) acc[a][b][m][n] = (f32x4){0.f, 0.f, 0.f, 0.f};
    bf16x8 At[4][2], B0[2][2], B1[2][2];
    const char* cA = (const char*)g.A + ((unsigned)cur.b * g.bsA * 2u + (unsigned)cur.pm * tA); const char* cB = (const char*)g.Bt + ((unsigned)cur.b * g.bsB * 2u + (unsigned)cur.pn * tB);
    PG8_STAGE(PG8_SB(0, 0), cB, voffB); PG8_STAGE(PG8_SB(0, 1), cB + hB, voffB); PG8_STAGE(PG8_SA(0, 0), cA, voffA); PG8_STAGE(PG8_SA(0, 1), cA + hA, voffA);
    if (wr == 1) PG8_BAR;
    PG8_WAIT_V(2); PG8_BAR;
    PG8_STAGE(PG8_SB(1, 0), cB + kstep, voffB); PG8_STAGE(PG8_SA(1, 0), cA + kstep, voffA); PG8_STAGE(PG8_SB(1, 1), cB + hB + kstep, voffB);
    PG8_WAIT_V(6); PG8_BAR;
    for (;;) {
        const bool has_next = S.next(ui + 1, nxt);
        const char* nA = has_next ? (const char*)g.A + ((unsigned)nxt.b * g.bsA * 2u + (unsigned)nxt.pm * tA) : cA; const char* nB = has_next ? (const char*)g.Bt + ((unsigned)nxt.b * g.bsB * 2u + (unsigned)nxt.pn * tB) : cB;
        for (int t = 0; t < nt; t += 2) {
            const bool last = (t == nt - 2);
            const char* a1 = cA + (unsigned)(t + 1) * kstep;
            const char* a2 = last ? nA : cA + (unsigned)(t + 2) * kstep; const char* b2 = last ? nB : cB + (unsigned)(t + 2) * kstep;
            const char* a3 = a2 + kstep; const char* b3 = b2 + kstep;
            PG8_LDB(B0, 0, 0); PG8_LDB(B1, 0, 1); PG8_SCHED; PG8_LDA(At, 0, 0); PG8_STAGE(PG8_SA(1, 1), a1 + hA, voffA);
            PG8_WAIT_V(8); PG8_WAIT_L(0); PG8_BAR; PG8_MMA(0, 0, At, B0); PG8_MMA(0, 1, At, B1); PG8_BAR; PG8_SCHED;
            PG8_LDA(At, 0, 1); PG8_STAGE(PG8_SB(0, 0), b2, voffB); PG8_STAGE(PG8_SB(0, 1), b2 + hB, voffB); PG8_STAGE(PG8_SA(0, 0), a2, voffA);
            PG8_WAIT_V(8); PG8_WAIT_L(0); PG8_BAR; PG8_MMA(1, 0, At, B0); PG8_MMA(1, 1, At, B1); PG8_BAR; PG8_SCHED;
            PG8_LDB(B0, 1, 0); PG8_LDB(B1, 1, 1); PG8_SCHED; PG8_LDA(At, 1, 0); PG8_STAGE(PG8_SA(0, 1), a2 + hA, voffA);
            PG8_WAIT_V(8); PG8_WAIT_L(0); PG8_BAR; PG8_MMA(0, 0, At, B0); PG8_MMA(0, 1, At, B1); PG8_BAR; PG8_SCHED;
            PG8_LDA(At, 1, 1); PG8_STAGE(PG8_SB(1, 0), b3, voffB); PG8_STAGE(PG8_SB(1, 1), b3 + hB, voffB); PG8_STAGE(PG8_SA(1, 0), a3, voffA);
            PG8_WAIT_V(8); PG8_WAIT_L(0); PG8_BAR; PG8_MMA(1, 0, At, B0); PG8_MMA(1, 1, At, B1); PG8_BAR; PG8_SCHED;
        }
        if (wr == 0) PG8_BAR;
        E(acc, cur, wr, wc, fr, fq);
        if (!has_next) break;
#pragma unroll
        for (int a = 0; a < 2; ++a)
#pragma unroll
            for (int b = 0; b < 2; ++b)
#pragma unroll
                for (int m = 0; m < 4; ++m)
#pragma unroll
                    for (int n = 0; n < 2; ++n) acc[a][b][m][n] = (f32x4){0.f, 0.f, 0.f, 0.f};
        cur = nxt; cA = nA; cB = nB; ++ui;
        if (wr == 1) PG8_BAR;
    }
    PG8_WAIT_V(0);
    PG8_BAR;
#undef PG8_SA
#undef PG8_SB
#undef PG8_STAGE
#undef PG8_LDA
#undef PG8_LDB
#undef PG8_MMA
#undef PG8_WAIT_V
#undef PG8_WAIT_L
#undef PG8_BAR
#undef PG8_SCHED
}
}

__device__ __forceinline__ void transpose_item(const float* W, int K, int N, bf16_t* WT, int halfN, LAS float* scr, int item, int lane) {
    const int nblk = N / 32, kb = item / nblk, nb = item % nblk, k0 = 64 * kb, n0 = 32 * nb;
    int r0 = n0; if (halfN) r0 = n0 < halfN ? (n0 / 128) * 256 + (n0 % 128) : ((n0 - halfN) / 128) * 256 + 128 + ((n0 - halfN) % 128);
#pragma unroll 8
    for (int i = 0; i < 32; ++i) { const int kk = 2 * i + (lane >> 5); scr[kk * 33 + (lane & 31)] = W[(size_t)(k0 + kk) * N + n0 + (lane & 31)]; }
    LDS_WAIT();
    const int c = lane & 7;
#pragma unroll
    for (int j = 0; j < 4; ++j) { const int n = (lane >> 3) + 8 * j; const LAS float* s = scr + (8 * c) * 33 + n;
        u32x4 o; o.x = cvt_pk_bf16(s[0 * 33], s[1 * 33]); o.y = cvt_pk_bf16(s[2 * 33], s[3 * 33]); o.z = cvt_pk_bf16(s[4 * 33], s[5 * 33]); o.w = cvt_pk_bf16(s[6 * 33], s[7 * 33]);
        *(u32x4*)(WT + (size_t)(r0 + n) * K + k0 + 8 * c) = o; }
    LDS_WAIT();
}

__device__ __forceinline__ void rowpass(int gw, int NGW, int lane, const float* h_in, float* h_out, const bf16_t* add, const float* g_add,
                                        bf16_t* out1, const float* g1, int mode1, bf16_t* out2, const float* g2) {
    for (int row = gw; row < L; row += NGW) {
        const f32x4* hp = (const f32x4*)(h_in + (size_t)row * D + 16 * lane);
        f32x4 v[4];
#pragma unroll
        for (int j = 0; j < 4; ++j) v[j] = hp[j];
        if (add) {
            const u32x4* ap = (const u32x4*)(add + (size_t)row * D + 16 * lane);
            const u32x4 a0 = ap[0], a1 = ap[1];
            f32x4 m[4];
            m[0] = (f32x4){bf_lo(a0.x), bf_hi(a0.x), bf_lo(a0.y), bf_hi(a0.y)}; m[1] = (f32x4){bf_lo(a0.z), bf_hi(a0.z), bf_lo(a0.w), bf_hi(a0.w)};
            m[2] = (f32x4){bf_lo(a1.x), bf_hi(a1.x), bf_lo(a1.y), bf_hi(a1.y)}; m[3] = (f32x4){bf_lo(a1.z), bf_hi(a1.z), bf_lo(a1.w), bf_hi(a1.w)};
            float ss = 0.f;
#pragma unroll
            for (int j = 0; j < 4; ++j) ss += (m[j][0] * m[j][0] + m[j][1] * m[j][1]) + (m[j][2] * m[j][2] + m[j][3] * m[j][3]);
            ss = wave_sum(ss);
            const float r = 1.0f / sqrtf(ss * (1.0f / D) + EPS);
            const f32x4* gp = (const f32x4*)(g_add + 16 * lane);
#pragma unroll
            for (int j = 0; j < 4; ++j) v[j] += m[j] * r * gp[j];
        }
        if (h_out) { f32x4* op = (f32x4*)(h_out + (size_t)row * D + 16 * lane);
#pragma unroll
            for (int j = 0; j < 4; ++j) op[j] = v[j]; }
        if (out1 || out2) {
            float ss = 0.f;
#pragma unroll
            for (int j = 0; j < 4; ++j) ss += (v[j][0] * v[j][0] + v[j][1] * v[j][1]) + (v[j][2] * v[j][2] + v[j][3] * v[j][3]);
            ss = wave_sum(ss);
            const float r = 1.0f / sqrtf(ss * (1.0f / D) + EPS);
            if (out1) {
                const f32x4* gp = (const f32x4*)(g1 + 16 * lane); unsigned w[8];
#pragma unroll
                for (int j = 0; j < 4; ++j) { const f32x4 o = v[j] * r * gp[j]; w[2 * j] = cvt_pk_bf16(o[0], o[1]); w[2 * j + 1] = cvt_pk_bf16(o[2], o[3]); }
                bf16_t* p = mode1 ? out1 + ((size_t)(lane * NCH + (row >> 4)) * AK + (row & 15) * 16) : out1 + (size_t)row * D + 16 * lane;
                ((u32x4*)p)[0] = (u32x4){w[0], w[1], w[2], w[3]}; ((u32x4*)p)[1] = (u32x4){w[4], w[5], w[6], w[7]};
            }
            if (out2) {
                const f32x4* gp = (const f32x4*)(g2 + 16 * lane); unsigned w[8];
#pragma unroll
                for (int j = 0; j < 4; ++j) { const f32x4 o = v[j] * r * gp[j]; w[2 * j] = cvt_pk_bf16(o[0], o[1]); w[2 * j + 1] = cvt_pk_bf16(o[2], o[3]); }
                bf16_t* p = out2 + (size_t)row * D + 16 * lane;
                ((u32x4*)p)[0] = (u32x4){w[0], w[1], w[2], w[3]}; ((u32x4*)p)[1] = (u32x4){w[4], w[5], w[6], w[7]};
            }
        }
    }
}

__device__ __forceinline__ f32x2 cmul(f32x2 a, f32x2 b) { return (f32x2){a.x * b.x - a.y * b.y, a.x * b.y + a.y * b.x}; }
__device__ __forceinline__ void cpow_d(double are, double aim, double dt, double n, double& re, double& im) {
    const double mag = exp(are * dt * n), ang = aim * dt * n;
    const double k = rint(ang * 0.15915494309189535), r = (ang - k * 6.283185307179586) - k * 2.4492935982947064e-16, r2 = r * r;
    double s = 0.0, ts = r, cc = 0.0, tc = 1.0;
    for (int q = 0; q < 16; ++q) { s += ts; cc += tc; ts *= -r2 / (double)((2 * q + 2) * (2 * q + 3)); tc *= -r2 / (double)((2 * q + 1) * (2 * q + 2)); }
    re = mag * cc; im = mag * s;
}
struct S5In { const float *log_dt, *a_re, *a_im, *b_re, *b_im, *c_re, *c_im; };
__device__ __forceinline__ void s5_precompute(LAS unsigned char* lds, const S5In& in, int l, int g, bf16_t* BT3, bf16_t* W1T, float* SC, int tid) {
    LAS f32x2* LP = (LAS f32x2*)lds;
    LAS f32x2* BB = LP + 17 * 64;
    LAS f32x2* CC = BB + 64 * 16;
    LAS float* KT = (LAS float*)(CC + 16 * 64);
    const int lg = l * NG + g;
    if (tid < 64) {
        const int p = tid;
        const double dt = exp((double)in.log_dt[lg]), are = (double)in.a_re[lg * 64 + p], aim = (double)in.a_im[lg * 64 + p];
        double lr = 1.0, li = 0.0;
        for (int d = 0; d <= 16; ++d) { double re, im; cpow_d(are, aim, dt, (double)d, re, im); LP[d * 64 + p] = (f32x2){(float)re, (float)im}; if (d == 1) { lr = re; li = im; } }
        const double nr = lr - 1.0, ni = li, den = are * are + aim * aim;
        const double fr_ = (nr * are + ni * aim) / den, fi_ = (ni * are - nr * aim) / den;
        for (int c = 0; c < 16; ++c) { const double br = (double)in.b_re[(size_t)(lg * 64 + p) * 16 + c], bi = (double)in.b_im[(size_t)(lg * 64 + p) * 16 + c];
            BB[p * 16 + c] = (f32x2){(float)(fr_ * br - fi_ * bi), (float)(fr_ * bi + fi_ * br)}; }
        double tr, ti, sr, si; cpow_d(are, aim, dt, 16.0, tr, ti); cpow_d(are, aim, dt, 512.0, sr, si);
        *(f32x4*)(SC + (size_t)(lg * 64 + p) * 4) = (f32x4){(float)tr, (float)ti, (float)sr, (float)si};
    }
    for (int idx = tid; idx < 1024; idx += 512) { const int c = idx >> 6, p = idx & 63; CC[c * 64 + p] = (f32x2){in.c_re[(size_t)(lg * 16 + c) * 64 + p], in.c_im[(size_t)(lg * 16 + c) * 64 + p]}; }
    __syncthreads();
    for (int idx = tid; idx < 4096; idx += 512) { const int d = idx >> 8, c = (idx >> 4) & 15, c2 = idx & 15; float s = 0.f;
        for (int p = 0; p < 64; ++p) { const f32x2 t = cmul(CC[c * 64 + p], LP[d * 64 + p]); const f32x2 b = BB[p * 16 + c2]; s += t.x * b.x - t.y * b.y; }
        KT[idx] = s; }
    __syncthreads();
    bf16_t* bt3 = BT3 + (size_t)lg * 256 * AK;
    for (int ch = tid; ch < 256 * 48; ch += 512) { const int n = ch / 48, kc = ch % 48, k0 = kc * 8, i = n >> 4, c = n & 15; float v[8];
        if (k0 < 256) { const int j = k0 >> 4, c0 = k0 & 15;
#pragma unroll
            for (int e = 0; e < 8; ++e) v[e] = (i >= j) ? KT[((i - j) * 16 + c) * 16 + c0 + e] : 0.f;
        } else { const int p0 = (k0 - 256) >> 1;
#pragma unroll
            for (int e = 0; e < 4; ++e) { const f32x2 t = cmul(CC[c * 64 + p0 + e], LP[(i + 1) * 64 + p0 + e]); v[2 * e] = t.x; v[2 * e + 1] = -t.y; } }
        *(u32x4*)(bt3 + (size_t)n * AK + k0) = (u32x4){cvt_pk_bf16(v[0], v[1]), cvt_pk_bf16(v[2], v[3]), cvt_pk_bf16(v[4], v[5]), cvt_pk_bf16(v[6], v[7])}; }
    bf16_t* w1t = W1T + (size_t)lg * 128 * 256;
    for (int ch = tid; ch < 128 * 32; ch += 512) { const int n = ch >> 5, kc = ch & 31, k0 = kc * 8, p = n >> 1, ri = n & 1, j = k0 >> 4, c0 = k0 & 15; float v[8];
#pragma unroll
        for (int e = 0; e < 8; ++e) { const f32x2 t = cmul(LP[(15 - j) * 64 + p], BB[p * 16 + c0 + e]); v[e] = ri ? t.y : t.x; }
        *(u32x4*)(w1t + (size_t)n * 256 + k0) = (u32x4){cvt_pk_bf16(v[0], v[1]), cvt_pk_bf16(v[2], v[3]), cvt_pk_bf16(v[4], v[5]), cvt_pk_bf16(v[6], v[7])}; }
    __syncthreads();
}

__device__ __forceinline__ void s5_scan(LAS unsigned char* lds, const float* S, const float* SC, bf16_t* Aext, int l, int G, int c, int tid) {
    const int pl = tid & 15, seg = tid >> 4;
    LAS f32x2* E = (LAS f32x2*)lds;
    for (int u = c; u < 256; u += G) {
        const int g = u >> 2, p = (u & 3) * 16 + pl;
        const f32x4 k4 = *(const f32x4*)(SC + (size_t)((l * NG + g) * 64 + p) * 4);
        const f32x2 lamT = (f32x2){k4[0], k4[1]}, lamS = (f32x2){k4[2], k4[3]};
        const float* sp = S + ((size_t)g * NCH + seg * 32) * 128 + 2 * p;
        f32x2 e = (f32x2){0.f, 0.f};
#pragma unroll 8
        for (int kk = 0; kk < 32; ++kk) { const f32x2 s = *(const f32x2*)(sp + (size_t)kk * 128); e = cmul(lamT, e) + s; }
        E[seg * 16 + pl] = e;
        __syncthreads();
        f32x2 x = (f32x2){0.f, 0.f};
        for (int s2 = 0; s2 < seg; ++s2) x = cmul(lamS, x) + E[s2 * 16 + pl];
        bf16_t* xp = Aext + ((size_t)g * NCH + seg * 32) * AK + 256 + 2 * p;
#pragma unroll 8
        for (int kk = 0; kk < 32; ++kk) { *(unsigned*)(xp + (size_t)kk * AK) = cvt_pk_bf16(x.x, x.y); const f32x2 s = *(const f32x2*)(sp + (size_t)kk * 128); x = cmul(lamT, x) + s; }
        __syncthreads();
    }
}

__device__ __forceinline__ void attn_phase(LAS unsigned char* lds, const bf16_t* Q, const bf16_t* Kb, const bf16_t* Vt, bf16_t* O, int G, int c, int tid) {
    const int w = __builtin_amdgcn_readfirstlane(tid >> 6), lane = tid & 63, fr = lane & 15, fq = lane >> 4;
    LAS unsigned char* ldsK = lds; LAS unsigned char* ldsV = lds + 18432; volatile LAS int* flags = (volatile LAS int*)(lds + 35840);
    for (int u = c; u < 2048; u += G) {
        const int h = u & 15, qb = u >> 4, ql = 16 * w + fr;
        const size_t qrow = (size_t)qb * 128 + ql;
        bf16x8 qf[2];
#pragma unroll
        for (int ks = 0; ks < 2; ++ks) qf[ks] = *(const bf16x8*)(Q + qrow * D + h * 64 + 32 * ks + 8 * fq);
        f32x4 oacc[4];
#pragma unroll
        for (int i = 0; i < 4; ++i) oacc[i] = (f32x4){0.f, 0.f, 0.f, 0.f};
        float log_rest = 0.f;
        for (int j = qb; j >= 0; --j) {
            __syncthreads();
            if (j < qb) { int all = 1;
#pragma unroll
                for (int i = 0; i < 8; ++i) all &= flags[i];
                if (all && !DIAG_NOEXIT) break; }
#pragma unroll
            for (int ii = 0; ii < 2; ++ii) { const int idx = tid + 512 * ii;
                { const int key = idx >> 3, ch = idx & 7; const u32x4 v = *(const u32x4*)(Kb + (size_t)(128 * j + key) * D + h * 64 + ch * 8); *(LAS u32x4*)(ldsK + key * 144 + ch * 16) = v; }
                { const int d = idx >> 4, ch = idx & 15; const u32x4 v = *(const u32x4*)(Vt + (size_t)(h * 64 + d) * L + 128 * j + ch * 8); *(LAS u32x4*)(ldsV + d * 272 + ch * 16) = v; } }
            __syncthreads();
            f32x4 z[8];
#pragma unroll
            for (int n = 0; n < 8; ++n) { z[n] = (f32x4){0.f, 0.f, 0.f, 0.f};
#pragma unroll
                for (int ks = 0; ks < 2; ++ks) { const bf16x8 a = *(const LAS bf16x8*)(ldsK + (16 * n + fr) * 144 + (32 * ks + 8 * fq) * 2); z[n] = __builtin_amdgcn_mfma_f32_16x16x32_bf16(a, qf[ks], z[n], 0, 0, 0); } }
            f32x4 l1[8]; float Gs[8];
            int lim = (j == qb) ? ql : 0x40000000; asm volatile("" : "+v"(lim));
#pragma unroll
            for (int n = 0; n < 8; ++n) {
#pragma unroll
                for (int r = 0; r < 4; ++r) { const float zz = z[n][r], sp = __logf(1.0f + __expf(-fabsf(zz))); const float lb = fminf(zz, 0.f) - sp; float lm = lb - zz;
                    const bool valid = (16 * n + 4 * fq + r) < lim; lm = valid ? lm : 0.f; z[n][r] = lb; l1[n][r] = lm; }
                Gs[n] = (l1[n][0] + l1[n][1]) + (l1[n][2] + l1[n][3]); }
            float Tn[8], sfx[8];
#pragma unroll
            for (int n = 0; n < 8; ++n) { const float g0 = Gs[n], g1 = __shfl_xor(g0, 16), g2 = __shfl_xor(g0, 32), g3 = __shfl_xor(g0, 48);
                const float v0 = fq == 0 ? g0 : fq == 1 ? g1 : fq == 2 ? g2 : g3;
                const float v1 = fq == 1 ? g0 : fq == 0 ? g1 : fq == 3 ? g2 : g3;
                const float v2 = fq == 2 ? g0 : fq == 3 ? g1 : fq == 0 ? g2 : g3;
                const float v3 = fq == 3 ? g0 : fq == 2 ? g1 : fq == 1 ? g2 : g3;
                Tn[n] = (v0 + v1) + (v2 + v3);
                sfx[n] = fq == 0 ? (v1 + v2) + v3 : fq == 1 ? v2 + v3 : fq == 2 ? v3 : 0.f; }
            float base = log_rest;
            unsigned pk[8][2];
#pragma unroll
            for (int n = 7; n >= 0; --n) { const float b0 = base + sfx[n];
                const float lt3 = b0, lt2 = b0 + l1[n][3], lt1 = lt2 + l1[n][2], lt0 = lt1 + l1[n][1];
                const int kb = 16 * n + 4 * fq;
                const float w0 = (kb + 0 < lim) ? __expf(z[n][0] + lt0) : 0.f, w1 = (kb + 1 < lim) ? __expf(z[n][1] + lt1) : 0.f, w2 = (kb + 2 < lim) ? __expf(z[n][2] + lt2) : 0.f, w3 = (kb + 3 < lim) ? __expf(z[n][3] + lt3) : 0.f;
                pk[n][0] = cvt_pk_bf16(w0, w1); pk[n][1] = cvt_pk_bf16(w2, w3);
                base += Tn[n]; }
            log_rest = base;
#pragma unroll
            for (int ks = 0; ks < 4; ++ks) {
                const u32x4 bwv = (u32x4){pk[2 * ks][0], pk[2 * ks][1], pk[2 * ks + 1][0], pk[2 * ks + 1][1]};
                const bf16x8 bw = __builtin_bit_cast(bf16x8, bwv);
#pragma unroll
                for (int nt = 0; nt < 4; ++nt) { const LAS unsigned char* vp = ldsV + (16 * nt + fr) * 272 + (32 * ks + 4 * fq) * 2;
                    const s16x4 lo = *(const LAS s16x4*)vp, hi = *(const LAS s16x4*)(vp + 32);
                    const bf16x8 a = __builtin_shufflevector(lo, hi, 0, 1, 2, 3, 4, 5, 6, 7);
                    oacc[nt] = __builtin_amdgcn_mfma_f32_16x16x32_bf16(a, bw, oacc[nt], 0, 0, 0); } }
            const int done = __all(log_rest <= -104.0f);
            if (lane == 0) flags[w] = done ? 1 : 0;
        }
#pragma unroll
        for (int nt = 0; nt < 4; ++nt) { u32x2 o; o.x = cvt_pk_bf16(oacc[nt][0], oacc[nt][1]); o.y = cvt_pk_bf16(oacc[nt][2], oacc[nt][3]);
            *(u32x2*)(O + qrow * D + h * 64 + 16 * nt + 4 * fq) = o; }
    }
}


__device__ __forceinline__ float bf1(const bf16_t* p) { return __uint_as_float(((unsigned)*p) << 16); }
__device__ __forceinline__ float wave_max(float v) {
#pragma unroll
    for (int o = 1; o < 64; o <<= 1) v = fmaxf(v, __shfl_xor(v, o));
    return v;
}
__device__ __forceinline__ void diag_s5(const S5In& in, const float* dskip, const bf16_t* Aext, const bf16_t* Y, float* res, int tid) {
    if (tid < 64) {
        const int p = tid, g = 5, lg = g;
        const double dtd = exp((double)in.log_dt[lg]), are = (double)in.a_re[lg * 64 + p], aim = (double)in.a_im[lg * 64 + p];
        double lr, li; cpow_d(are, aim, dtd, 1.0, lr, li);
        const double nr = lr - 1.0, ni = li, den = are * are + aim * aim;
        const double fr_ = (nr * are + ni * aim) / den, fi_ = (ni * are - nr * aim) / den;
        const f32x2 lam = (f32x2){(float)lr, (float)li};
        f32x2 bb[16], cc[16]; float dd[16];
#pragma unroll
        for (int c = 0; c < 16; ++c) { const double br = (double)in.b_re[(size_t)(lg * 64 + p) * 16 + c], bi = (double)in.b_im[(size_t)(lg * 64 + p) * 16 + c];
            bb[c] = (f32x2){(float)(fr_ * br - fi_ * bi), (float)(fr_ * bi + fi_ * br)};
            cc[c] = (f32x2){in.c_re[(size_t)(lg * 16 + c) * 64 + p], in.c_im[(size_t)(lg * 16 + c) * 64 + p]}; dd[c] = dskip[g * 16 + c]; }
        f32x2 x = (f32x2){0.f, 0.f}; float maxd = 0.f, maxa = 0.f;
        for (int t = 0; t < 2048; ++t) {
            const bf16_t* up = Aext + ((size_t)(g * NCH + (t >> 4)) * AK + (t & 15) * 16);
            const u32x4 u0 = *(const u32x4*)up, u1 = *((const u32x4*)up + 1);
            float uu[16] = {bf_lo(u0.x), bf_hi(u0.x), bf_lo(u0.y), bf_hi(u0.y), bf_lo(u0.z), bf_hi(u0.z), bf_lo(u0.w), bf_hi(u0.w), bf_lo(u1.x), bf_hi(u1.x), bf_lo(u1.y), bf_hi(u1.y), bf_lo(u1.z), bf_hi(u1.z), bf_lo(u1.w), bf_hi(u1.w)};
            f32x2 bu = (f32x2){0.f, 0.f};
#pragma unroll
            for (int c = 0; c < 16; ++c) bu += bb[c] * uu[c];
            x = cmul(lam, x) + bu;
#pragma unroll
            for (int c = 0; c < 16; ++c) { float yc = cc[c].x * x.x - cc[c].y * x.y; yc = wave_sum(yc); yc += dd[c] * uu[c];
                const float tt = 1.5957691216057308f * (yc + 0.044715f * yc * yc * yc); yc = yc / (1.0f + expf(-tt));
                const float got = bf1(Y + (size_t)t * D + g * 16 + c); maxd = fmaxf(maxd, fabsf(yc - got)); maxa = fmaxf(maxa, fabsf(yc)); }
        }
        if (p == 0) res[0] = maxd / maxa;
    }
}
__device__ __forceinline__ void diag_attn(const bf16_t* Q, const bf16_t* Kb, const bf16_t* Vt, const bf16_t* O, float* res, int tid) {
    const int w = tid >> 6, d = tid & 63;
    const int t = 40 * 128 + (w == 0 ? 0 : w == 1 ? 15 : w == 2 ? 16 : w == 3 ? 64 : w == 4 ? 100 : w == 5 ? 120 : w == 6 ? 125 : 127), h = 3;
    const float q = bf1(Q + (size_t)t * D + h * 64 + d);
    float acc = 0.f, o = 0.f; const int s_lo = t - 600 > 0 ? t - 600 : 0;
    for (int s = t - 1; s >= s_lo; --s) { const float z = wave_sum(q * bf1(Kb + (size_t)s * D + h * 64 + d)); const float sp = logf(1.0f + expf(-fabsf(z))), lb = fminf(z, 0.f) - sp;
        const float wgt = expf(lb + acc); acc += lb - z; o += wgt * bf1(Vt + (size_t)(h * 64 + d) * L + s); }
    const float got = bf1(O + (size_t)t * D + h * 64 + d);
    const float dd = wave_max(fabsf(o - got)), aa = wave_max(fabsf(o));
    if (d == 0) res[1 + w] = dd / aa;
}
__device__ __forceinline__ float digit_of(float err) { float dgt = -2.0f * log10f(fmaxf(err, 1e-6f)); return fminf(fmaxf(rintf(dgt), 0.f), 9.f); }

struct Args { const float* in[22]; float* out; unsigned char* ws; int ph_lo, ph_hi; };

__global__ void __launch_bounds__(512, 2) mk_fwd(Args a) {
    extern __shared__ __attribute__((aligned(16))) unsigned char lds_raw[];
    LAS unsigned char* lds = (LAS unsigned char*)lds_raw;
    cg::grid_group grid = cg::this_grid();
    const int G0 = gridDim.x, c0 = blockIdx.x;
    typedef const __attribute__((address_space(4))) Args* KArgs;
    const int lo = a.ph_lo, hi = a.ph_hi; (void)lo; (void)hi;
    int ph = 0; (void)ph;
#if MK_ONE_LAUNCH
#define PH_COND true
#define PH_SYNC(last) if (!(last)) grid.sync();
#else
#define PH_COND (ph >= lo && ph < hi)
#define PH_SYNC(last)
#endif
#define PH_BEGIN if (PH_COND) { int tid = threadIdx.x; asm volatile("" : "+v"(tid)); int c = c0, G = G0; asm volatile("" : "+s"(c), "+s"(G)); const int NGW = G * 8; (void)NGW; const int lane = tid & 63, wave = __builtin_amdgcn_readfirstlane(tid >> 6), gw = c * 8 + wave; (void)lane; (void)gw; \
    KArgs ap = (KArgs)__builtin_amdgcn_kernarg_segment_ptr(); asm volatile("" : "+s"(ap)); unsigned char* ws = ap->ws; float* out = ap->out; const float* x = ap->in[0]; (void)out; (void)x; \
    bf16_t* WIN = (bf16_t*)(ws + WS_WIN); bf16_t* WOUT = (bf16_t*)(ws + WS_WOUT); bf16_t* WGLU = (bf16_t*)(ws + WS_WGLU); \
    bf16_t* WK = (bf16_t*)(ws + WS_WK); bf16_t* WV = (bf16_t*)(ws + WS_WV); bf16_t* WQ = (bf16_t*)(ws + WS_WQ); bf16_t* WO = (bf16_t*)(ws + WS_WO); \
    bf16_t* BT3 = (bf16_t*)(ws + WS_BT3); bf16_t* W1T = (bf16_t*)(ws + WS_W1T); float* SC = (float*)(ws + WS_SC); \
    bf16_t* AEXT = (bf16_t*)(ws + WS_AEXT); float* Sb = (float*)(ws + WS_S); bf16_t* ACT = (bf16_t*)(ws + WS_ACT); bf16_t* MIX = (bf16_t*)(ws + WS_MIX); \
    bf16_t* VT = (bf16_t*)(ws + WS_VT); bf16_t* KB = (bf16_t*)(ws + WS_KB); bf16_t* Yb = (bf16_t*)(ws + WS_Y); bf16_t* Qb = (bf16_t*)(ws + WS_Q); bf16_t* Ob = (bf16_t*)(ws + WS_O); bf16_t* HK = (bf16_t*)(ws + WS_HK); \
    (void)WIN; (void)WOUT; (void)WGLU; (void)WK; (void)WV; (void)WQ; (void)WO; (void)BT3; (void)W1T; (void)SC; (void)AEXT; (void)Sb; (void)ACT; (void)MIX; (void)VT; (void)KB; (void)Yb; (void)Qb; (void)Ob; (void)HK;
#define PH_END   PH_SYNC(false) } ++ph;
#define PH_END_LAST(last)   PH_SYNC(last) } ++ph;

    PH_BEGIN
        if (c < 128) { S5In in{ap->in[7], ap->in[8], ap->in[9], ap->in[10], ap->in[11], ap->in[12], ap->in[13]}; s5_precompute(lds, in, c >> 6, c & 63, BT3, W1T, SC, tid); }
        LAS float* scr = (LAS float*)(lds + wave * 16384);
        constexpr int I_IN = 16 * 176, I_OUT = 44 * 32, I_GLU = 16 * 64, I_SQ = 16 * 32;
        constexpr int NITEMS = 4 * I_IN + 4 * I_OUT + 2 * I_GLU + 6 * I_SQ;
        for (int it = gw; it < NITEMS; it += NGW) {
            int r = it;
            if (r < 4 * I_IN) { const int l = r / I_IN; transpose_item(ap->in[5] + (size_t)l * D * 2 * DFF, D, 2 * DFF, WIN + (size_t)l * 2 * DFF * D, DFF, scr, r % I_IN, lane); continue; } r -= 4 * I_IN;
            if (r < 4 * I_OUT) { const int l = r / I_OUT; transpose_item(ap->in[6] + (size_t)l * DFF * D, DFF, D, WOUT + (size_t)l * D * DFF, 0, scr, r % I_OUT, lane); continue; } r -= 4 * I_OUT;
            if (r < 2 * I_GLU) { const int l = r / I_GLU; transpose_item(ap->in[15] + (size_t)l * D * 2 * D, D, 2 * D, WGLU + (size_t)l * 2 * D * D, D, scr, r % I_GLU, lane); continue; } r -= 2 * I_GLU;
            const int wsel = r / I_SQ; r %= I_SQ;
            const float* src = wsel == 0 ? ap->in[18] : wsel == 1 ? ap->in[19] : wsel < 4 ? ap->in[20] + (size_t)(wsel - 2) * D * D : ap->in[21] + (size_t)(wsel - 4) * D * D;
            bf16_t* dst = wsel == 0 ? WK : wsel == 1 ? WV : wsel < 4 ? WQ + (size_t)(wsel - 2) * D * D : WO + (size_t)(wsel - 4) * D * D;
            transpose_item(src, D, D, dst, 0, scr, r, lane);
        }
        rowpass(gw, NGW, lane, x, nullptr, nullptr, nullptr, AEXT, ap->in[1], 1, nullptr, nullptr);
    PH_END

    for (int l = 0; l < 4; ++l) {
        if (l < 2) {
            PH_BEGIN
                pg8::Gemm g{AEXT, W1T + (size_t)l * NG * 128 * 256, NCH, 256, 256, AK, 256, NG, (unsigned)NCH * AK, 128u * 256u};
                pg8::EpiS5State E{Sb}; pg8::gemm_phase(lds, g, E, G, c, tid);
            PH_END
            PH_BEGIN
                s5_scan(lds, Sb, SC, AEXT, l, G, c, tid);
            PH_END
            PH_BEGIN
                pg8::Gemm g{AEXT, BT3 + (size_t)l * NG * 256 * AK, NCH, 256, AK, AK, AK, NG, (unsigned)NCH * AK, 256u * AK};
                pg8::EpiS5Out E{AEXT, ap->in[14] + (size_t)l * NG * 16, Yb}; pg8::gemm_phase(lds, g, E, G, c, tid);
            PH_END
            PH_BEGIN
#if DIAG == 1
                if (l == 0) { if (c == 0) { S5In in{ap->in[7], ap->in[8], ap->in[9], ap->in[10], ap->in[11], ap->in[12], ap->in[13]}; diag_s5(in, ap->in[14], AEXT, Yb, (float*)ws, tid); if (tid == 0) out[0] = (digit_of(((float*)ws)[0]) + 1.f) * 10000.f; } return; }
#endif
                pg8::Gemm g{Yb, WGLU + (size_t)l * 2 * D * D, L, 2 * D, D, D, D, 1, 0, 0};
                pg8::EpiGLU E{MIX, D, ap->in[16] + (size_t)l * 2 * D, D}; pg8::gemm_phase(lds, g, E, G, c, tid);
            PH_END
        } else {
            const int b = l - 2;
            PH_BEGIN
                if (l == 2) {
                    { pg8::Gemm g{HK, WK, L, D, D, D, D, 1, 0, 0}; pg8::EpiPlain E{KB, D, 1.0f}; pg8::gemm_phase(lds, g, E, G, c, tid); }
                    { pg8::Gemm g{WV, HK, D, L, D, D, D, 1, 0, 0}; pg8::EpiPlain E{VT, L, 1.0f}; pg8::gemm_phase(lds, g, E, G, c, tid); }
                }
                { pg8::Gemm g{MIX, WQ + (size_t)b * D * D, L, D, D, D, D, 1, 0, 0}; pg8::EpiPlain E{Qb, D, 0.125f}; pg8::gemm_phase(lds, g, E, G, c, tid); }
#if DIAG == 2
                grid.sync(); __threadfence(); grid.sync();
#endif
            PH_END
            PH_BEGIN
                attn_phase(lds, Qb, KB, VT, Ob, G, c, tid);
            PH_END
            PH_BEGIN
#if DIAG == 2
                if (l == 2) { if (c == 1) { diag_attn(Qb, KB, VT, Ob, (float*)ws, tid); __syncthreads(); if (tid == 0) { const float* res = (const float*)ws; int lo4 = 0, hi4 = 0; for (int i = 0; i < 4; ++i) { if (res[1 + i] > 0.1f) lo4 |= 1 << i; if (res[5 + i] > 0.1f) hi4 |= 1 << i; } float V = (10.f + (float)lo4) * 1000.f; for (int i = 0; i < hi4; ++i) V *= 10.f; out[0] = V; } } return; }
#endif
                pg8::Gemm g{Ob, WO + (size_t)b * D * D, L, D, D, D, D, 1, 0, 0}; pg8::EpiPlain E{MIX, D, 1.0f}; pg8::gemm_phase(lds, g, E, G, c, tid);
            PH_END
        }
        PH_BEGIN
            rowpass(gw, NGW, lane, l == 0 ? x : out, out, MIX, ap->in[2] + l * D, MIX, ap->in[3] + l * D, 0, nullptr, nullptr);
        PH_END
        PH_BEGIN
            pg8::Gemm g{MIX, WIN + (size_t)l * 2 * DFF * D, L, 2 * DFF, D, D, D, 1, 0, 0};
            pg8::EpiSwiGLU E{ACT, DFF}; pg8::gemm_phase(lds, g, E, G, c, tid);
        PH_END
        PH_BEGIN
            pg8::Gemm g{ACT, WOUT + (size_t)l * D * DFF, L, D, DFF, DFF, DFF, 1, 0, 0};
            pg8::EpiPlain E{MIX, D, 1.0f}; pg8::gemm_phase(lds, g, E, G, c, tid);
        PH_END
        PH_BEGIN
            if (l == 0)      rowpass(gw, NGW, lane, out, out, MIX, ap->in[4] + l * D, AEXT, ap->in[1] + (l + 1) * D, 1, nullptr, nullptr);
            else if (l == 1) rowpass(gw, NGW, lane, out, out, MIX, ap->in[4] + l * D, MIX, ap->in[1] + (l + 1) * D, 0, HK, ap->in[17]);
            else if (l == 2) rowpass(gw, NGW, lane, out, out, MIX, ap->in[4] + l * D, MIX, ap->in[1] + (l + 1) * D, 0, nullptr, nullptr);
            else             rowpass(gw, NGW, lane, out, out, MIX, ap->in[4] + l * D, nullptr, nullptr, 0, nullptr, nullptr);
        PH_END_LAST(l == 3)
    }
#undef PH_BEGIN
#undef PH_END
#undef PH_END_LAST
}
constexpr int N_PHASES = 1 + 2 * 8 + 2 * 7;

extern "C" void kernel_launch(void* const* d_in, const int* in_sizes, int n_in, void* d_out, int out_size, void* d_ws, size_t ws_size, hipStream_t stream) {
    static int grid = 0;
    if (grid == 0) {
        if (n_in != 22 || in_sizes[0] != L * D || out_size != L * D || ws_size < WS_END) { fprintf(stderr, "kernel_launch: unexpected shapes (n_in %d in0 %d out %d ws %zu)\n", n_in, n_in > 0 ? in_sizes[0] : -1, out_size, ws_size); grid = -1; return; }
        int dev = 0, cus = 0, per_cu = 0;
        hipGetDevice(&dev); hipDeviceGetAttribute(&cus, hipDeviceAttributeMultiprocessorCount, dev);
        if (hipFuncSetAttribute((const void*)mk_fwd, hipFuncAttributeMaxDynamicSharedMemorySize, LDS_BYTES) != hipSuccess) { fprintf(stderr, "kernel_launch: hipFuncSetAttribute failed\n"); grid = -1; return; }
        if (hipOccupancyMaxActiveBlocksPerMultiprocessor(&per_cu, (const void*)mk_fwd, 512, LDS_BYTES) != hipSuccess || per_cu < 1) { fprintf(stderr, "kernel_launch: occupancy query says %d blocks/CU\n", per_cu); grid = -1; return; }
        grid = cus;
    }
    if (grid < 0) return;
    Args a{};
    for (int i = 0; i < 22; ++i) a.in[i] = (const float*)d_in[i];
    a.out = (float*)d_out; a.ws = (unsigned char*)d_ws;
#if MK_ONE_LAUNCH
    a.ph_lo = 0; a.ph_hi = N_PHASES;
    void* args[] = {&a};
    hipError_t e = hipLaunchCooperativeKernel((const void*)mk_fwd, dim3(grid), dim3(512), args, LDS_BYTES, stream);
    if (e != hipSuccess) fprintf(stderr, "cooperative launch failed: %s (grid %d)\n", hipGetErrorString(e), grid);
#else
    for (int p = 0; p < N_PHASES; ++p) { a.ph_lo = p; a.ph_hi = p + 1; hipLaunchKernelGGL(mk_fwd, dim3(grid), dim3(512), LDS_BYTES, stream, a); }
#endif
}
```

```cpp
#include <hip/hip_runtime.h>
#include <hip/hip_cooperative_groups.h>
#include <cstdio>
#include <cstdint>
namespace cg = cooperative_groups;

#ifndef DIAG
#define DIAG 0
#endif
#ifndef USE_CG_SYNC
#define USE_CG_SYNC 0
#endif
#ifndef EXTRA_SYNCS
#define EXTRA_SYNCS 0
#endif
#ifndef DUP_GROUP
#define DUP_GROUP -1
#endif
#define DUPFOR(k) for (int rep_ = 0; rep_ < ((DUP_GROUP == (k)) ? 2 : 1); ++rep_)
#ifndef DIAG_GROUP
#define DIAG_GROUP 2
#endif
#ifndef DIAG_NOEXIT
#define DIAG_NOEXIT 0
#endif
#ifndef DIAG_NIB
#define DIAG_NIB 0
#endif
#ifndef MK_ONE_LAUNCH
#define MK_ONE_LAUNCH 1
#endif

#define LAS __attribute__((address_space(3)))
typedef unsigned short bf16_t;
typedef short bf16x8 __attribute__((ext_vector_type(8)));
typedef short s16x4 __attribute__((ext_vector_type(4)));
typedef float f32x4 __attribute__((ext_vector_type(4)));
typedef float f32x2 __attribute__((ext_vector_type(2)));
typedef unsigned u32x4 __attribute__((ext_vector_type(4)));
typedef unsigned u32x2 __attribute__((ext_vector_type(2)));

constexpr int L = 16384, D = 1024, DFF = 2816, NG = 64, NCH = 1024, AK = 384;
constexpr float EPS = 1e-6f;
constexpr size_t MiB = 1u << 20;
constexpr size_t WS_WIN = 1 * MiB, WS_WOUT = 45 * MiB, WS_WGLU = 67 * MiB, WS_WK = 75 * MiB, WS_WV = 77 * MiB, WS_WQ = 79 * MiB, WS_WO = 83 * MiB;
constexpr size_t WS_BT3 = 87 * MiB, WS_W1T = 111 * MiB, WS_SC = 120 * MiB, WS_AEXT = 121 * MiB, WS_S = 169 * MiB, WS_ACT = 201 * MiB, WS_MIX = 289 * MiB, WS_XCH = 321 * MiB, WS_END = 325 * MiB;
constexpr size_t WS_VT = WS_AEXT, WS_KB = WS_S, WS_Y = WS_ACT, WS_Q = WS_ACT, WS_O = WS_ACT + 32 * MiB, WS_HK = WS_BT3;
constexpr int LDS_BYTES = 147456;
constexpr size_t WS_CNT = 65536, WS_CNT2 = 320 * 1024, CTL_ZERO_BYTES = 512 * 1024;

typedef __bf16 bf16x2_t __attribute__((ext_vector_type(2)));
__device__ __forceinline__ unsigned cvt_pk_bf16(float lo, float hi) { const f32x2 v = {lo, hi}; const bf16x2_t b = __builtin_convertvector(v, bf16x2_t); return __builtin_bit_cast(unsigned, b); }
__device__ __forceinline__ float bf_lo(unsigned w) { return __uint_as_float(w << 16); }
__device__ __forceinline__ float bf_hi(unsigned w) { return __uint_as_float(w & 0xffff0000u); }
__device__ __forceinline__ float wave_sum(float v) {
#pragma unroll
    for (int o = 1; o < 64; o <<= 1) v += __shfl_xor(v, o);
    return v;
}
#define LDS_WAIT() asm volatile("s_waitcnt lgkmcnt(0)" ::: "memory")

namespace pg8 {
constexpr int BM = 256, BK = 64, HALF = 128, HTB = HALF * BK * 2, NXCD = 8, WGM = 8;
__device__ __forceinline__ int lds_byte(int r, int c) { const int st = (r >> 4) * 2 + (c >> 5), rr = r & 15, cc = c & 31, ob = rr * 64 + cc * 2; return st * 1024 + (ob ^ (((ob >> 9) & 1) << 5)); }
__device__ __forceinline__ void stage_rc(int b, int& R, int& C) { const int st = b / 1024, sb = b % 1024, swz = sb ^ (((sb >> 9) & 1) << 5); R = (st >> 1) * 16 + swz / 64; C = (st & 1) * 32 + (swz % 64) / 2; }

__device__ __forceinline__ int perm32(int rho) { const int n = rho >> 4, i = rho & 15; return 8 * (i >> 2) + 4 * n + (i & 3); }
template <class T, class = void> struct epi_perm { static constexpr bool value = false; };
template <class T> struct epi_perm<T, decltype((void)T::PERM)> { static constexpr bool value = T::PERM; };
struct Unit { int pm, pn, b; };
struct Gemm { const bf16_t* A; const bf16_t* Bt; int M, N, K, lda, ldb, batch; unsigned bsA, bsB; };
struct Order {
    int nM, nN, per, total, G, c;
    __device__ __forceinline__ void init(int M, int N, int batch, int G_, int c_) { nM = M / BM; nN = N / BM; per = nM * nN; total = per * batch; G = G_; c = c_; }
    __device__ __forceinline__ bool next(int i, Unit& u) const {
        const int Lx = i * G + c; if (Lx >= total) return false;
        if (per == 4 && G == 256 && total == 256) { u.b = (c & 7) * 8 + (c >> 5); u.pm = (c >> 3) & 3; u.pn = 0; return true; }
        u.b = Lx / per; int wgid = Lx - u.b * per;
        { const int q = per / NXCD, r = per % NXCD, xcd = wgid % NXCD, off = wgid / NXCD; wgid = (xcd < r ? xcd * (q + 1) : r * (q + 1) + (xcd - r) * q) + off; }
        const int nig = WGM * nN, gid = wgid / nig, fm = gid * WGM, gsz = (nM - fm) < WGM ? (nM - fm) : WGM;
        u.pm = fm + ((wgid % nig) % gsz); u.pn = (wgid % nig) / gsz; return true;
    }
};

struct EpiPlain {
    static constexpr bool PERM = true;
    bf16_t* O; int ldc; float scale;
    __device__ __forceinline__ void operator()(const f32x4 (&acc)[2][2][4][2], const Unit& u, int wr, int wc, int fr, int fq) const {
        const int row0 = u.pm * BM + wr * 64 + fr, col0 = u.pn * BM + wc * 32 + 8 * fq;
#pragma unroll
        for (int ai = 0; ai < 2; ++ai)
#pragma unroll
            for (int m = 0; m < 4; ++m) { bf16_t* rowp = O + (size_t)(row0 + ai * HALF + m * 16) * ldc + col0;
#pragma unroll
                for (int bj = 0; bj < 2; ++bj) { const f32x4 v0 = acc[ai][bj][m][0] * scale, v1 = acc[ai][bj][m][1] * scale;
                    *(u32x4*)(rowp + bj * HALF) = (u32x4){cvt_pk_bf16(v0[0], v0[1]), cvt_pk_bf16(v0[2], v0[3]), cvt_pk_bf16(v1[0], v1[1]), cvt_pk_bf16(v1[2], v1[3])}; } }
    }
};
struct EpiSwiGLU {
    static constexpr bool PERM = true;
    bf16_t* O; int ldc;
    __device__ __forceinline__ void operator()(const f32x4 (&acc)[2][2][4][2], const Unit& u, int wr, int wc, int fr, int fq) const {
        const int row0 = u.pm * BM + wr * 64 + fr, col0 = u.pn * HALF + wc * 32 + 8 * fq;
#pragma unroll
        for (int ai = 0; ai < 2; ++ai)
#pragma unroll
            for (int m = 0; m < 4; ++m) { bf16_t* rowp = O + (size_t)(row0 + ai * HALF + m * 16) * ldc + col0; unsigned w[4];
#pragma unroll
                for (int n = 0; n < 2; ++n) { const f32x4 g = acc[ai][0][m][n], up = acc[ai][1][m][n]; f32x4 v;
#pragma unroll
                    for (int e = 0; e < 4; ++e) v[e] = g[e] * up[e] * __builtin_amdgcn_rcpf(1.0f + __expf(-g[e]));
                    w[2 * n] = cvt_pk_bf16(v[0], v[1]); w[2 * n + 1] = cvt_pk_bf16(v[2], v[3]); }
                *(u32x4*)rowp = (u32x4){w[0], w[1], w[2], w[3]}; }
    }
};
struct EpiGLU {
    static constexpr bool PERM = true;
    bf16_t* O; int ldc; const float* bias; int halfN;
    __device__ __forceinline__ void operator()(const f32x4 (&acc)[2][2][4][2], const Unit& u, int wr, int wc, int fr, int fq) const {
        const int row0 = u.pm * BM + wr * 64 + fr, col0 = u.pn * HALF + wc * 32 + 8 * fq;
        f32x4 bv[2], bg[2];
#pragma unroll
        for (int n = 0; n < 2; ++n) { bv[n] = *(const f32x4*)(bias + col0 + 4 * n); bg[n] = *(const f32x4*)(bias + halfN + col0 + 4 * n); }
#pragma unroll
        for (int ai = 0; ai < 2; ++ai)
#pragma unroll
            for (int m = 0; m < 4; ++m) { bf16_t* rowp = O + (size_t)(row0 + ai * HALF + m * 16) * ldc + col0; unsigned w[4];
#pragma unroll
                for (int n = 0; n < 2; ++n) { const f32x4 a = acc[ai][0][m][n] + bv[n], g = acc[ai][1][m][n] + bg[n]; f32x4 v;
#pragma unroll
                    for (int e = 0; e < 4; ++e) v[e] = a[e] * __builtin_amdgcn_rcpf(1.0f + __expf(-g[e]));
                    w[2 * n] = cvt_pk_bf16(v[0], v[1]); w[2 * n + 1] = cvt_pk_bf16(v[2], v[3]); }
                *(u32x4*)rowp = (u32x4){w[0], w[1], w[2], w[3]}; }
    }
};
struct EpiS5State {
    static constexpr bool AFTER_DRAIN = true;
    __device__ __forceinline__ void fused(const f32x4 (&acc)[2][2][4][2], const Unit& u, int wr, int wc, int fr, int fq, LAS unsigned char* lds, int wid, int lane) const {
        LAS float* St = (LAS float*)lds;
#pragma unroll
        for (int ai = 0; ai < 2; ++ai)
#pragma unroll
            for (int m = 0; m < 4; ++m) { const int lr = ai * HALF + wr * 64 + m * 16 + fr;
#pragma unroll
                for (int n = 0; n < 2; ++n) *(LAS f32x4*)(St + lr * 128 + wc * 32 + n * 16 + 4 * fq) = acc[ai][0][m][n]; }
    }
};
struct EpiS5Out {
    const bf16_t* Aext; const float* dskip; bf16_t* Y;
    __device__ __forceinline__ void operator()(const f32x4 (&acc)[2][2][4][2], const Unit& u, int wr, int wc, int fr, int fq) const {
        const int row0 = u.pm * BM + wr * 64 + fr;
        const f32x4 dv = *(const f32x4*)(dskip + u.b * 16 + 4 * fq);
#pragma unroll
        for (int ai = 0; ai < 2; ++ai)
#pragma unroll
            for (int m = 0; m < 4; ++m) { const int row = row0 + ai * HALF + m * 16; const bf16_t* up = Aext + ((size_t)u.b * NCH + row) * AK + wc * 32 + 4 * fq;
#pragma unroll
                for (int bj = 0; bj < 2; ++bj)
#pragma unroll
                    for (int n = 0; n < 2; ++n) { const u32x2 uu = *(const u32x2*)(up + bj * HALF + n * 16); const f32x4 a = acc[ai][bj][m][n];
                        f32x4 v; v[0] = a[0] + dv[0] * bf_lo(uu.x); v[1] = a[1] + dv[1] * bf_hi(uu.x); v[2] = a[2] + dv[2] * bf_lo(uu.y); v[3] = a[3] + dv[3] * bf_hi(uu.y);
#pragma unroll
                        for (int e = 0; e < 4; ++e) { const float x = v[e], t = 1.5957691216057308f * (x + 0.044715f * x * x * x); v[e] = x * __builtin_amdgcn_rcpf(1.0f + __expf(-t)); }
                        const int i = 8 * bj + 2 * wc + n; u32x2 w; w.x = cvt_pk_bf16(v[0], v[1]); w.y = cvt_pk_bf16(v[2], v[3]);
                        *(u32x2*)(Y + (size_t)(row * 16 + i) * D + u.b * 16 + 4 * fq) = w; } }
    }
};


struct EpiResNorm {
    static constexpr bool AFTER_DRAIN = true, PERM = true;
    const bf16_t* hin; int hin_pitch; bf16_t* hout; int hout_pitch; float* hout_f; const float* g_post;
    bf16_t* out1; const float* g1; int mode1; bf16_t* out2; const float* g2;
    float* xch; unsigned* cnt; int inst;
    __device__ __forceinline__ void exchange(const float (&part)[2][4], const Unit& u, int wr, int wc, int fr, int fq, LAS unsigned char* lds, int wid, int lane, int ex) const {
        LAS float* P = (LAS float*)lds; LAS float* S = (LAS float*)(lds + 4096);
        const int tid = wid * 64 + lane;
#pragma unroll
        for (int ai = 0; ai < 2; ++ai)
#pragma unroll
            for (int m = 0; m < 4; ++m) { float sq = part[ai][m]; sq += __shfl_xor(sq, 16); sq += __shfl_xor(sq, 32); if (fq == 0) P[(ai * HALF + wr * 64 + m * 16 + fr) * 4 + wc] = sq; }
        asm volatile("s_waitcnt lgkmcnt(0)" ::: "memory"); __builtin_amdgcn_s_barrier(); asm volatile("" ::: "memory");
        float* slots = xch + ((size_t)((inst * 2 + ex) * 64 + u.pm) * 256) * 4; unsigned* cw = cnt + ((inst * 2 + ex) * 64 + u.pm) * 64;
        if (tid < 256) { const float tot = (P[tid * 4] + P[tid * 4 + 1]) + (P[tid * 4 + 2] + P[tid * 4 + 3]); __hip_atomic_store(slots + tid * 4 + u.pn, tot, __ATOMIC_RELAXED, __HIP_MEMORY_SCOPE_AGENT); }
        asm volatile("s_waitcnt vmcnt(0)" ::: "memory");
        if (wid < 4 && lane == 0) __hip_atomic_fetch_add(cw, 1u, __ATOMIC_RELAXED, __HIP_MEMORY_SCOPE_AGENT);
        if (wid == 0) { unsigned sp = 0;
            while ((unsigned)__builtin_amdgcn_readfirstlane(__hip_atomic_load(cw, __ATOMIC_RELAXED, __HIP_MEMORY_SCOPE_AGENT)) < 16u) { __builtin_amdgcn_s_sleep(1); if (++sp > (1u << 22)) break; }
            __builtin_amdgcn_fence(__ATOMIC_ACQUIRE, "agent"); }
        asm volatile("s_waitcnt vmcnt(0) lgkmcnt(0)" ::: "memory"); __builtin_amdgcn_s_barrier(); asm volatile("" ::: "memory");
        if (tid < 256) { float t4 = 0.f;
#pragma unroll
            for (int t = 0; t < 4; ++t) t4 += __hip_atomic_load(slots + tid * 4 + t, __ATOMIC_RELAXED, __HIP_MEMORY_SCOPE_AGENT);
            S[tid] = 1.0f / sqrtf(t4 * (1.0f / D) + EPS); }
        asm volatile("s_waitcnt lgkmcnt(0)" ::: "memory"); __builtin_amdgcn_s_barrier(); asm volatile("" ::: "memory");
    }
    __device__ __forceinline__ void fused(f32x4 (&acc)[2][2][4][2], const Unit& u, int wr, int wc, int fr, int fq, LAS unsigned char* lds, int wid, int lane) const {
        const LAS float* S = (const LAS float*)(lds + 4096);
        const int col0 = u.pn * BM + wc * 32 + 8 * fq;
        float part[2][4];
#pragma unroll
        for (int ai = 0; ai < 2; ++ai)
#pragma unroll
            for (int m = 0; m < 4; ++m) { float sq = 0.f;
#pragma unroll
                for (int bj = 0; bj < 2; ++bj)
#pragma unroll
                    for (int n = 0; n < 2; ++n) { const f32x4 a = acc[ai][bj][m][n]; sq += (a[0] * a[0] + a[1] * a[1]) + (a[2] * a[2] + a[3] * a[3]); }
                part[ai][m] = sq; }
        u32x4 ht[2][4][2];
#pragma unroll
        for (int ai = 0; ai < 2; ++ai)
#pragma unroll
            for (int m = 0; m < 4; ++m)
#pragma unroll
                for (int bj = 0; bj < 2; ++bj) ht[ai][m][bj] = *(const u32x4*)(hin + ((size_t)u.pm * BM + ai * HALF + wr * 64 + m * 16 + fr) * hin_pitch + col0 + bj * HALF);
        f32x4 gp[2][2];
#pragma unroll
        for (int bj = 0; bj < 2; ++bj)
#pragma unroll
            for (int n = 0; n < 2; ++n) gp[bj][n] = *(const f32x4*)(g_post + col0 + bj * HALF + 4 * n);
        exchange(part, u, wr, wc, fr, fq, lds, wid, lane, 0);
#pragma unroll
        for (int ai = 0; ai < 2; ++ai)
#pragma unroll
            for (int m = 0; m < 4; ++m) { const int lr = ai * HALF + wr * 64 + m * 16 + fr; const size_t row = (size_t)u.pm * BM + lr; const float rs = S[lr]; float sq = 0.f;
#pragma unroll
                for (int bj = 0; bj < 2; ++bj) { const int col = col0 + bj * HALF; const u32x4 t = ht[ai][m][bj];
                    f32x4 h0 = (f32x4){bf_lo(t.x), bf_hi(t.x), bf_lo(t.y), bf_hi(t.y)} + acc[ai][bj][m][0] * rs * gp[bj][0];
                    f32x4 h1 = (f32x4){bf_lo(t.z), bf_hi(t.z), bf_lo(t.w), bf_hi(t.w)} + acc[ai][bj][m][1] * rs * gp[bj][1];
                    if (hout_f) { *(f32x4*)(hout_f + row * D + col) = h0; *(f32x4*)(hout_f + row * D + col + 4) = h1; }
                    else { const u32x4 w = (u32x4){cvt_pk_bf16(h0[0], h0[1]), cvt_pk_bf16(h0[2], h0[3]), cvt_pk_bf16(h1[0], h1[1]), cvt_pk_bf16(h1[2], h1[3])}; *(u32x4*)(hout + row * hout_pitch + col) = w;
                        h0 = (f32x4){bf_lo(w.x), bf_hi(w.x), bf_lo(w.y), bf_hi(w.y)}; h1 = (f32x4){bf_lo(w.z), bf_hi(w.z), bf_lo(w.w), bf_hi(w.w)}; }
                    acc[ai][bj][m][0] = h0; acc[ai][bj][m][1] = h1;
                    sq += ((h0[0] * h0[0] + h0[1] * h0[1]) + (h0[2] * h0[2] + h0[3] * h0[3])) + ((h1[0] * h1[0] + h1[1] * h1[1]) + (h1[2] * h1[2] + h1[3] * h1[3])); }
                part[ai][m] = sq; }
        if (!out1) return;
        exchange(part, u, wr, wc, fr, fq, lds, wid, lane, 1);
#pragma unroll
        for (int bj = 0; bj < 2; ++bj)
#pragma unroll
            for (int n = 0; n < 2; ++n) gp[bj][n] = *(const f32x4*)(g1 + col0 + bj * HALF + 4 * n);
#pragma unroll
        for (int ai = 0; ai < 2; ++ai)
#pragma unroll
            for (int m = 0; m < 4; ++m) { const int lr = ai * HALF + wr * 64 + m * 16 + fr; const int row = u.pm * BM + lr; const float rs = S[lr];
#pragma unroll
                for (int bj = 0; bj < 2; ++bj) { const int col = col0 + bj * HALF; const f32x4 o0 = acc[ai][bj][m][0] * rs * gp[bj][0], o1 = acc[ai][bj][m][1] * rs * gp[bj][1];
                    bf16_t* p = mode1 ? out1 + ((size_t)((col >> 4) * NCH + (row >> 4)) * AK + (row & 15) * 16 + (col & 15)) : out1 + (size_t)row * D + col;
                    *(u32x4*)p = (u32x4){cvt_pk_bf16(o0[0], o0[1]), cvt_pk_bf16(o0[2], o0[3]), cvt_pk_bf16(o1[0], o1[1]), cvt_pk_bf16(o1[2], o1[3])}; } }
        if (out2) {
#pragma unroll
            for (int bj = 0; bj < 2; ++bj)
#pragma unroll
                for (int n = 0; n < 2; ++n) gp[bj][n] = *(const f32x4*)(g2 + col0 + bj * HALF + 4 * n);
#pragma unroll
            for (int ai = 0; ai < 2; ++ai)
#pragma unroll
                for (int m = 0; m < 4; ++m) { const int lr = ai * HALF + wr * 64 + m * 16 + fr; const size_t row = (size_t)u.pm * BM + lr; const float rs = S[lr];
#pragma unroll
                    for (int bj = 0; bj < 2; ++bj) { const int col = col0 + bj * HALF; const f32x4 o0 = acc[ai][bj][m][0] * rs * gp[bj][0], o1 = acc[ai][bj][m][1] * rs * gp[bj][1];
                        *(u32x4*)(out2 + row * D + col) = (u32x4){cvt_pk_bf16(o0[0], o0[1]), cvt_pk_bf16(o0[2], o0[3]), cvt_pk_bf16(o1[0], o1[1]), cvt_pk_bf16(o1[2], o1[3])}; } }
        }
    }
};

template <class T, class = void> struct epi_after_drain { static constexpr bool value = false; };
template <class T> struct epi_after_drain<T, decltype((void)T::AFTER_DRAIN)> { static constexpr bool value = T::AFTER_DRAIN; };
template <class Epi>
__device__ __forceinline__ void gemm_phase(LAS unsigned char* lds, const Gemm g, const Epi& E, int G, int c, int tid) {
    const int wid = __builtin_amdgcn_readfirstlane(tid >> 6), lane = tid & 63, wr = wid >> 2, wc = wid & 3, fr = lane & 15, fq = lane >> 4;
    const int nt = g.K / BK;
    unsigned voffA[2], voffB[2];
#pragma unroll
    for (int i = 0; i < 2; ++i) { int R, C; stage_rc(tid * 16 + i * 8192, R, C); voffA[i] = (unsigned)(R * g.lda + C) * 2u; const int Rb = epi_perm<Epi>::value ? ((R & ~31) + perm32(R & 31)) : R; voffB[i] = (unsigned)(Rb * g.ldb + C) * 2u; }
    constexpr unsigned kstep = BK * 2;
    const unsigned hA = (unsigned)HALF * g.lda * 2, hB = (unsigned)HALF * g.ldb * 2, tA = 2 * hA, tB = 2 * hB;
    const unsigned ldsw = (unsigned)wid * 1024u;
    const int aoff = lds_byte(wr * 64 + fr, fq * 8), boff = lds_byte(wc * 32 + fr, fq * 8);
#define PG8_SA(b, h) (((b) * 2 + (h)) * HTB)
#define PG8_SB(b, h) ((4 + (b) * 2 + (h)) * HTB)
#define PG8_STAGE(bufoff, gbase, voff) do { _Pragma("unroll") for (int _i = 0; _i < 2; ++_i) \
        __builtin_amdgcn_global_load_lds((const unsigned*)((const char*)(gbase) + (voff)[_i]), (LAS unsigned*)(lds + (bufoff) + ldsw + _i * 8192), 16, 0, 0); } while (0)
#define PG8_LDA(dst, b, h) do { _Pragma("unroll") for (int m = 0; m < 4; ++m) _Pragma("unroll") for (int k = 0; k < 2; ++k) dst[m][k] = *(const LAS bf16x8*)(lds + PG8_SA(b, h) + aoff + m * 2048 + k * 1024); } while (0)
#define PG8_LDB(dst, b, h) do { _Pragma("unroll") for (int n = 0; n < 2; ++n) _Pragma("unroll") for (int k = 0; k < 2; ++k) dst[n][k] = *(const LAS bf16x8*)(lds + PG8_SB(b, h) + boff + n * 2048 + k * 1024); } while (0)
#define PG8_MMA(ai, bj, At, Bt) do { __builtin_amdgcn_s_setprio(1); _Pragma("unroll") for (int m = 0; m < 4; ++m) _Pragma("unroll") for (int n = 0; n < 2; ++n) _Pragma("unroll") for (int k = 0; k < 2; ++k) \
        acc[ai][bj][m][n] = __builtin_amdgcn_mfma_f32_16x16x32_bf16(Bt[n][k], At[m][k], acc[ai][bj][m][n], 0, 0, 0); __builtin_amdgcn_s_setprio(0); } while (0)
#define PG8_WAIT_V(n) asm volatile("s_waitcnt vmcnt(" #n ")" ::: "memory")
#define PG8_WAIT_L(n) asm volatile("s_waitcnt lgkmcnt(" #n ")" ::: "memory")
#define PG8_BAR __builtin_amdgcn_s_barrier()
#define PG8_SCHED __builtin_amdgcn_sched_barrier(0)
    Order S; S.init(g.M, g.N, g.batch, G, c);
    Unit cur, nxt; int ui = 0;
    if (!S.next(0, cur)) return;
    f32x4 acc[2][2][4][2];
#pragma unroll
    for (int a = 0; a < 2; ++a)
#pragma unroll
        for (int b = 0; b < 2; ++b)
#pragma unroll
            for (int m = 0; m < 4; ++m)
#pragma unroll
                for (int n = 0; n < 2; ++n) acc[a][b][m][n] = (f32x4){0.f, 0.f, 0.f, 0.f};
    bf16x8 At[4][2], B0[2][2], B1[2][2];
    const char* cA = (const char*)g.A + ((unsigned)cur.b * g.bsA * 2u + (unsigned)cur.pm * tA); const char* cB = (const char*)g.Bt + ((unsigned)cur.b * g.bsB * 2u + (unsigned)cur.pn * tB);
    PG8_STAGE(PG8_SB(0, 0), cB, voffB); PG8_STAGE(PG8_SB(0, 1), cB + hB, voffB); PG8_STAGE(PG8_SA(0, 0), cA, voffA); PG8_STAGE(PG8_SA(0, 1), cA + hA, voffA);
    if (wr == 1) PG8_BAR;
    PG8_WAIT_V(2); PG8_BAR;
    PG8_STAGE(PG8_SB(1, 0), cB + kstep, voffB); PG8_STAGE(PG8_SA(1, 0), cA + kstep, voffA); PG8_STAGE(PG8_SB(1, 1), cB + hB + kstep, voffB);
    PG8_WAIT_V(6); PG8_BAR;
    for (;;) {
        const bool has_next = S.next(ui + 1, nxt);
        const char* nA = has_next ? (const char*)g.A + ((unsigned)nxt.b * g.bsA * 2u + (unsigned)nxt.pm * tA) : cA; const char* nB = has_next ? (const char*)g.Bt + ((unsigned)nxt.b * g.bsB * 2u + (unsigned)nxt.pn * tB) : cB;
        for (int t = 0; t < nt; t += 2) {
            const bool last = (t == nt - 2);
            const char* a1 = cA + (unsigned)(t + 1) * kstep;
            const char* a2 = last ? nA : cA + (unsigned)(t + 2) * kstep; const char* b2 = last ? nB : cB + (unsigned)(t + 2) * kstep;
            const char* a3 = a2 + kstep; const char* b3 = b2 + kstep;
            PG8_LDB(B0, 0, 0); PG8_LDB(B1, 0, 1); PG8_SCHED; PG8_LDA(At, 0, 0); PG8_STAGE(PG8_SA(1, 1), a1 + hA, voffA);
            PG8_WAIT_V(8); PG8_WAIT_L(0); PG8_BAR; PG8_MMA(0, 0, At, B0); PG8_MMA(0, 1, At, B1); PG8_BAR; PG8_SCHED;
            PG8_LDA(At, 0, 1); PG8_STAGE(PG8_SB(0, 0), b2, voffB); PG8_STAGE(PG8_SB(0, 1), b2 + hB, voffB); PG8_STAGE(PG8_SA(0, 0), a2, voffA);
            PG8_WAIT_V(8); PG8_WAIT_L(0); PG8_BAR; PG8_MMA(1, 0, At, B0); PG8_MMA(1, 1, At, B1); PG8_BAR; PG8_SCHED;
            PG8_LDB(B0, 1, 0); PG8_LDB(B1, 1, 1); PG8_SCHED; PG8_LDA(At, 1, 0); PG8_STAGE(PG8_SA(0, 1), a2 + hA, voffA);
            PG8_WAIT_V(8); PG8_WAIT_L(0); PG8_BAR; PG8_MMA(0, 0, At, B0); PG8_MMA(0, 1, At, B1); PG8_BAR; PG8_SCHED;
            PG8_LDA(At, 1, 1); PG8_STAGE(PG8_SB(1, 0), b3, voffB); PG8_STAGE(PG8_SB(1, 1), b3 + hB, voffB); PG8_STAGE(PG8_SA(1, 0), a3, voffA);
            PG8_WAIT_V(8); PG8_WAIT_L(0); PG8_BAR; PG8_MMA(1, 0, At, B0); PG8_MMA(1, 1, At, B1); PG8_BAR; PG8_SCHED;
        }
        constexpr bool AD = epi_after_drain<Epi>::value;
        if constexpr (!AD) { if (wr == 0) PG8_BAR;
            E(acc, cur, wr, wc, fr, fq); }
        if (!has_next) break;
#pragma unroll
        for (int a = 0; a < 2; ++a)
#pragma unroll
            for (int b = 0; b < 2; ++b)
#pragma unroll
                for (int m = 0; m < 4; ++m)
#pragma unroll
                    for (int n = 0; n < 2; ++n) acc[a][b][m][n] = (f32x4){0.f, 0.f, 0.f, 0.f};
        cur = nxt; cA = nA; cB = nB; ++ui;
        if constexpr (!epi_after_drain<Epi>::value) { if (wr == 1) PG8_BAR; }
    }
    PG8_WAIT_V(0);
    if constexpr (epi_after_drain<Epi>::value) { if (wr == 0) PG8_BAR; }
    PG8_BAR;
    if constexpr (epi_after_drain<Epi>::value) E.fused(acc, cur, wr, wc, fr, fq, lds, wid, lane);
#undef PG8_SA
#undef PG8_SB
#undef PG8_STAGE
#undef PG8_LDA
#undef PG8_LDB
#undef PG8_MMA
#undef PG8_WAIT_V
#undef PG8_WAIT_L
#undef PG8_BAR
#undef PG8_SCHED
}
}

__device__ __forceinline__ void transpose_item(const float* W, int K, int N, bf16_t* WT, int halfN, LAS unsigned short* scr, int item, int lane) {
    const int nblk = N / 64, kb = item / nblk, nb = item % nblk, k0 = 64 * kb, n0 = 64 * nb;
    int r0 = n0; if (halfN) r0 = n0 < halfN ? (n0 / 128) * 256 + (n0 % 128) : ((n0 - halfN) / 128) * 256 + 128 + ((n0 - halfN) % 128);
    const int lk = lane >> 4, ln = (lane & 15) * 4;
    f32x4 t[16];
#pragma unroll
    for (int i = 0; i < 16; ++i) t[i] = *(const f32x4*)(W + (size_t)(k0 + 4 * i + lk) * N + n0 + ln);
#pragma unroll
    for (int i = 0; i < 16; ++i) { u32x2 w; w.x = cvt_pk_bf16(t[i][0], t[i][1]); w.y = cvt_pk_bf16(t[i][2], t[i][3]);
        LAS unsigned* p = (LAS unsigned*)(scr + (4 * i + lk) * 66 + ln); p[0] = w.x; p[1] = w.y; }
    LDS_WAIT();
    const int c = lane & 7;
#pragma unroll
    for (int j = 0; j < 8; ++j) { const int n = (lane >> 3) + 8 * j; const LAS unsigned short* sp = scr + (8 * c) * 66 + n;
        u32x4 o; o.x = (unsigned)sp[0] | ((unsigned)sp[66] << 16); o.y = (unsigned)sp[2 * 66] | ((unsigned)sp[3 * 66] << 16); o.z = (unsigned)sp[4 * 66] | ((unsigned)sp[5 * 66] << 16); o.w = (unsigned)sp[6 * 66] | ((unsigned)sp[7 * 66] << 16);
        *(u32x4*)(WT + (size_t)(r0 + n) * K + k0 + 8 * c) = o; }
    LDS_WAIT();
}

constexpr int NR = 4;
__device__ __forceinline__ void rowpass(int gw, int NGW, int lane, const float* h_f32, float* hbuf, int hin_mode, int hout_mode, const bf16_t* add, const float* g_add,
                                        bf16_t* out1, const float* g1, int mode1, bf16_t* out2, const float* g2) {
    for (int row0 = gw * NR; row0 < L; row0 += NGW * NR) {
        f32x4 v[NR][4]; u32x2 av[NR][4];
        if (hin_mode == 0) {
#pragma unroll
            for (int r = 0; r < NR; ++r)
#pragma unroll
                for (int j = 0; j < 4; ++j) v[r][j] = ((const f32x4*)(h_f32 + (size_t)(row0 + r) * D))[64 * j + lane];
        } else {
#pragma unroll
            for (int r = 0; r < NR; ++r)
#pragma unroll
                for (int j = 0; j < 4; ++j) { const u32x2 t = ((const u32x2*)((const bf16_t*)hbuf + (size_t)(row0 + r) * 2 * D + D))[64 * j + lane]; v[r][j] = (f32x4){bf_lo(t.x), bf_hi(t.x), bf_lo(t.y), bf_hi(t.y)}; }
        }
        if (add) {
#pragma unroll
            for (int r = 0; r < NR; ++r)
#pragma unroll
                for (int j = 0; j < 4; ++j) av[r][j] = ((const u32x2*)(add + (size_t)(row0 + r) * D))[64 * j + lane];
            float ss[NR];
#pragma unroll
            for (int r = 0; r < NR; ++r) { float s_ = 0.f;
#pragma unroll
                for (int j = 0; j < 4; ++j) { const float a0 = bf_lo(av[r][j].x), a1 = bf_hi(av[r][j].x), a2 = bf_lo(av[r][j].y), a3 = bf_hi(av[r][j].y); s_ += (a0 * a0 + a1 * a1) + (a2 * a2 + a3 * a3); }
                ss[r] = s_; }
#pragma unroll
            for (int o = 1; o < 64; o <<= 1)
#pragma unroll
                for (int r = 0; r < NR; ++r) ss[r] += __shfl_xor(ss[r], o);
#pragma unroll
            for (int r = 0; r < NR; ++r) ss[r] = 1.0f / sqrtf(ss[r] * (1.0f / D) + EPS);
#pragma unroll
            for (int j = 0; j < 4; ++j) { const f32x4 gg = ((const f32x4*)g_add)[64 * j + lane];
#pragma unroll
                for (int r = 0; r < NR; ++r) { const f32x4 m = (f32x4){bf_lo(av[r][j].x), bf_hi(av[r][j].x), bf_lo(av[r][j].y), bf_hi(av[r][j].y)}; v[r][j] += m * ss[r] * gg; } }
        }
        if (hout_mode == 1) {
#pragma unroll
            for (int r = 0; r < NR; ++r)
#pragma unroll
                for (int j = 0; j < 4; ++j) { u32x2 w; w.x = cvt_pk_bf16(v[r][j][0], v[r][j][1]); w.y = cvt_pk_bf16(v[r][j][2], v[r][j][3]);
                    ((u32x2*)((bf16_t*)hbuf + (size_t)(row0 + r) * 2 * D + D))[64 * j + lane] = w; v[r][j] = (f32x4){bf_lo(w.x), bf_hi(w.x), bf_lo(w.y), bf_hi(w.y)}; }
        } else if (hout_mode == 2) {
#pragma unroll
            for (int r = 0; r < NR; ++r)
#pragma unroll
                for (int j = 0; j < 4; ++j) ((f32x4*)(hbuf + (size_t)(row0 + r) * D))[64 * j + lane] = v[r][j];
        }
        if (out1 || out2) {
            float ss[NR];
#pragma unroll
            for (int r = 0; r < NR; ++r) { float s_ = 0.f;
#pragma unroll
                for (int j = 0; j < 4; ++j) s_ += (v[r][j][0] * v[r][j][0] + v[r][j][1] * v[r][j][1]) + (v[r][j][2] * v[r][j][2] + v[r][j][3] * v[r][j][3]);
                ss[r] = s_; }
#pragma unroll
            for (int o = 1; o < 64; o <<= 1)
#pragma unroll
                for (int r = 0; r < NR; ++r) ss[r] += __shfl_xor(ss[r], o);
#pragma unroll
            for (int r = 0; r < NR; ++r) ss[r] = 1.0f / sqrtf(ss[r] * (1.0f / D) + EPS);
            if (out1) {
#pragma unroll
                for (int j = 0; j < 4; ++j) { const f32x4 gg = ((const f32x4*)g1)[64 * j + lane];
#pragma unroll
                    for (int r = 0; r < NR; ++r) { const f32x4 o = v[r][j] * ss[r] * gg; u32x2 w; w.x = cvt_pk_bf16(o[0], o[1]); w.y = cvt_pk_bf16(o[2], o[3]); const int row = row0 + r;
                        bf16_t* p = mode1 ? out1 + ((size_t)((16 * j + (lane >> 2)) * NCH + (row >> 4)) * AK + (row & 15) * 16 + 4 * (lane & 3)) : out1 + (size_t)row * D + 256 * j + 4 * lane;
                        *(u32x2*)p = w; } }
            }
            if (out2) {
#pragma unroll
                for (int j = 0; j < 4; ++j) { const f32x4 gg = ((const f32x4*)g2)[64 * j + lane];
#pragma unroll
                    for (int r = 0; r < NR; ++r) { const f32x4 o = v[r][j] * ss[r] * gg; u32x2 w; w.x = cvt_pk_bf16(o[0], o[1]); w.y = cvt_pk_bf16(o[2], o[3]);
                        *(u32x2*)(out2 + (size_t)(row0 + r) * D + 256 * j + 4 * lane) = w; } }
            }
        }
    }
}

__device__ __forceinline__ f32x2 cmul(f32x2 a, f32x2 b) { return (f32x2){a.x * b.x - a.y * b.y, a.x * b.y + a.y * b.x}; }
__device__ __forceinline__ void cpow_d(double are, double aim, double dt, double n, double& re, double& im) {
    const double mag = exp(are * dt * n), ang = aim * dt * n;
    const double k = rint(ang * 0.15915494309189535), r = (ang - k * 6.283185307179586) - k * 2.4492935982947064e-16, r2 = r * r;
    double s = 0.0, ts = r, cc = 0.0, tc = 1.0;
#pragma unroll
    for (int q = 0; q < 16; ++q) { s += ts; cc += tc; ts *= -r2 * (1.0 / (double)((2 * q + 2) * (2 * q + 3))); tc *= -r2 * (1.0 / (double)((2 * q + 1) * (2 * q + 2))); }
    re = mag * cc; im = mag * s;
}
struct S5In { const float *log_dt, *a_re, *a_im, *b_re, *b_im, *c_re, *c_im; };
__device__ __forceinline__ void s5_precompute(LAS unsigned char* lds, const S5In& in, int l, int g, bf16_t* BT3, bf16_t* W1T, float* SC, int tid) {
    LAS f32x2* LP = (LAS f32x2*)lds;
    LAS f32x2* BB = LP + 17 * 64;
    LAS f32x2* CC = BB + 64 * 16;
    LAS float* KT = (LAS float*)(CC + 16 * 64);
    const int lg = l * NG + g;
    LAS f32x2* LS = (LAS f32x2*)(KT + 4096);
    {
        const int p = tid & 63, dg = tid >> 6;
        const double dt = exp((double)in.log_dt[lg]), are = (double)in.a_re[lg * 64 + p], aim = (double)in.a_im[lg * 64 + p];
        for (int d = dg; d <= 16; d += 8) { double re, im; cpow_d(are, aim, dt, (double)d, re, im); LP[d * 64 + p] = (f32x2){(float)re, (float)im}; }
        if (dg == 7) { double re, im; cpow_d(are, aim, dt, 512.0, re, im); LS[p] = (f32x2){(float)re, (float)im}; }
        if (dg == 6) {
            double lr, li; cpow_d(are, aim, dt, 1.0, lr, li);
            const double nr = lr - 1.0, ni = li, den = are * are + aim * aim;
            const double fr_ = (nr * are + ni * aim) / den, fi_ = (ni * are - nr * aim) / den;
            for (int c = 0; c < 16; ++c) { const double br = (double)in.b_re[(size_t)(lg * 64 + p) * 16 + c], bi = (double)in.b_im[(size_t)(lg * 64 + p) * 16 + c];
                BB[p * 16 + c] = (f32x2){(float)(fr_ * br - fi_ * bi), (float)(fr_ * bi + fi_ * br)}; }
        }
    }
    for (int idx = tid; idx < 1024; idx += 512) { const int c = idx >> 6, p = idx & 63; CC[c * 64 + p] = (f32x2){in.c_re[(size_t)(lg * 16 + c) * 64 + p], in.c_im[(size_t)(lg * 16 + c) * 64 + p]}; }
    __syncthreads();
    if (tid < 64) { const f32x2 lt = LP[16 * 64 + tid], ls = LS[tid]; *(f32x4*)(SC + (size_t)(lg * 64 + tid) * 4) = (f32x4){lt.x, lt.y, ls.x, ls.y}; }
    for (int idx = tid; idx < 4096; idx += 512) { const int d = idx >> 8, c = (idx >> 4) & 15, c2 = idx & 15; float s = 0.f;
        for (int p = 0; p < 64; ++p) { const f32x2 t = cmul(CC[c * 64 + p], LP[d * 64 + p]); const f32x2 b = BB[p * 16 + c2]; s += t.x * b.x - t.y * b.y; }
        KT[idx] = s; }
    __syncthreads();
    bf16_t* bt3 = BT3 + (size_t)lg * 256 * AK;
    for (int ch = tid; ch < 256 * 48; ch += 512) { const int n = ch / 48, kc = ch % 48, k0 = kc * 8, i = n >> 4, c = n & 15; float v[8];
        if (k0 < 256) { const int j = k0 >> 4, c0 = k0 & 15;
#pragma unroll
            for (int e = 0; e < 8; ++e) v[e] = (i >= j) ? KT[((i - j) * 16 + c) * 16 + c0 + e] : 0.f;
        } else { const int p0 = (k0 - 256) >> 1;
#pragma unroll
            for (int e = 0; e < 4; ++e) { const f32x2 t = cmul(CC[c * 64 + p0 + e], LP[(i + 1) * 64 + p0 + e]); v[2 * e] = t.x; v[2 * e + 1] = -t.y; } }
        *(u32x4*)(bt3 + (size_t)n * AK + k0) = (u32x4){cvt_pk_bf16(v[0], v[1]), cvt_pk_bf16(v[2], v[3]), cvt_pk_bf16(v[4], v[5]), cvt_pk_bf16(v[6], v[7])}; }
    bf16_t* w1t = W1T + (size_t)lg * 128 * 256;
    for (int ch = tid; ch < 128 * 32; ch += 512) { const int n = ch >> 5, kc = ch & 31, k0 = kc * 8, p = n >> 1, ri = n & 1, j = k0 >> 4, c0 = k0 & 15; float v[8];
#pragma unroll
        for (int e = 0; e < 8; ++e) { const f32x2 t = cmul(LP[(15 - j) * 64 + p], BB[p * 16 + c0 + e]); v[e] = ri ? t.y : t.x; }
        *(u32x4*)(w1t + (size_t)n * 256 + k0) = (u32x4){cvt_pk_bf16(v[0], v[1]), cvt_pk_bf16(v[2], v[3]), cvt_pk_bf16(v[4], v[5]), cvt_pk_bf16(v[6], v[7])}; }
    __syncthreads();
}

__device__ __forceinline__ void s5_scan(LAS unsigned char* lds, const float* S, const float* SC, bf16_t* Aext, float* xq, unsigned* cq, int l, int G, int c, int tid) {
    const int p = tid & 63, seg = tid >> 6, lane = tid & 63;
    LAS f32x2* E = (LAS f32x2*)(lds + 131072 + 512);
    for (int u = c; u < 256; u += G) {
        const int g = (G == 256) ? (u & 7) * 8 + (u >> 5) : (u >> 2), q = (G == 256) ? (u >> 3) & 3 : (u & 3);
        const f32x4 k4 = *(const f32x4*)(SC + (size_t)((l * NG + g) * 64 + p) * 4);
        const f32x2 lamT = (f32x2){k4[0], k4[1]}, lamS = (f32x2){k4[2], k4[3]};
        f32x2 lamQ = lamS;
#pragma unroll
        for (int i = 0; i < 3; ++i) lamQ = cmul(lamQ, lamQ);
        const LAS float* sp = (const LAS float*)lds + (seg * 32) * 128 + 2 * p;
        f32x2 sv[32];
#pragma unroll
        for (int kk = 0; kk < 32; ++kk) sv[kk] = *(const LAS f32x2*)(sp + kk * 128);
        f32x2 e = (f32x2){0.f, 0.f};
#pragma unroll
        for (int kk = 0; kk < 32; ++kk) e = cmul(lamT, e) + sv[kk];
        E[seg * 64 + p] = e;
        __syncthreads();
        float* slots = xq + (size_t)((l * NG + g) * 4) * 128; unsigned* cw = cq + (l * NG + g) * 64;
        if (seg == 0) {
            f32x2 t = (f32x2){0.f, 0.f};
#pragma unroll
            for (int s2 = 0; s2 < 8; ++s2) t = cmul(lamS, t) + E[s2 * 64 + p];
            __hip_atomic_store(slots + q * 128 + 2 * p, t.x, __ATOMIC_RELAXED, __HIP_MEMORY_SCOPE_AGENT);
            __hip_atomic_store(slots + q * 128 + 2 * p + 1, t.y, __ATOMIC_RELAXED, __HIP_MEMORY_SCOPE_AGENT);
            asm volatile("s_waitcnt vmcnt(0)" ::: "memory");
            if (lane == 0) __hip_atomic_fetch_add(cw, 1u, __ATOMIC_RELAXED, __HIP_MEMORY_SCOPE_AGENT);
            unsigned spn = 0;
            while ((unsigned)__builtin_amdgcn_readfirstlane(__hip_atomic_load(cw, __ATOMIC_RELAXED, __HIP_MEMORY_SCOPE_AGENT)) < 4u) { __builtin_amdgcn_s_sleep(1); if (++spn > (1u << 22)) break; }
            __builtin_amdgcn_fence(__ATOMIC_ACQUIRE, "agent");
            f32x2 cin = (f32x2){0.f, 0.f};
            for (int q2 = 0; q2 < q; ++q2) { const f32x2 tq = (f32x2){__hip_atomic_load(slots + q2 * 128 + 2 * p, __ATOMIC_RELAXED, __HIP_MEMORY_SCOPE_AGENT), __hip_atomic_load(slots + q2 * 128 + 2 * p + 1, __ATOMIC_RELAXED, __HIP_MEMORY_SCOPE_AGENT)};
                cin = cmul(lamQ, cin) + tq; }
            E[8 * 64 + p] = cin;
        }
        __syncthreads();
        f32x2 x = E[8 * 64 + p];
        for (int s2 = 0; s2 < seg; ++s2) x = cmul(lamS, x) + E[s2 * 64 + p];
        bf16_t* xp = Aext + ((size_t)g * NCH + q * 256 + seg * 32) * AK + 256 + 2 * p;
#pragma unroll
        for (int kk = 0; kk < 32; ++kk) { *(unsigned*)(xp + (size_t)kk * AK) = cvt_pk_bf16(x.x, x.y); x = cmul(lamT, x) + sv[kk]; }
        asm volatile("s_waitcnt vmcnt(0)" ::: "memory");
        __syncthreads();
    }
}

template <bool DIAGB>
__device__ __forceinline__ bool attn_block(LAS unsigned char* ldsK, LAS unsigned char* ldsV, const bf16x8 (&qf)[2], f32x4 (&oacc)[4], float& log_rest, int w, int fr, int fq, int ql, int bp16, int bp32) {
    int lim = ql; asm volatile("" : "+v"(lim));
    float base = log_rest;
    bool done = false;
#pragma unroll
    for (int ks = 3; ks >= 0; --ks) {
        if ((!DIAGB || 2 * ks <= w) && !done) {
            f32x4 z[2], l1[2]; float Gs[2];
#pragma unroll
            for (int t = 0; t < 2; ++t) { const int n = 2 * ks + t;
                z[t] = (f32x4){0.f, 0.f, 0.f, 0.f};
#pragma unroll
                for (int kk = 0; kk < 2; ++kk) { const bf16x8 a = *(const LAS bf16x8*)(ldsK + (16 * n + fr) * 144 + (32 * kk + 8 * fq) * 2); z[t] = __builtin_amdgcn_mfma_f32_16x16x32_bf16(a, qf[kk], z[t], 0, 0, 0); }
#pragma unroll
                for (int r = 0; r < 4; ++r) { const float zz = z[t][r], sp = __builtin_amdgcn_logf(1.0f + __builtin_amdgcn_exp2f(-fabsf(zz))); const float mn = __builtin_amdgcn_fmed3f(zz, 0.f, -3.0e38f); const float lb = mn - sp; float lm = lb - zz;
                    if (DIAGB) { const bool valid = (16 * n + 4 * fq + r) < lim; lm = valid ? lm : 0.f; }
                    z[t][r] = lb; l1[t][r] = lm; }
                Gs[t] = (l1[t][0] + l1[t][1]) + (l1[t][2] + l1[t][3]); }
            unsigned pk[2][2];
#pragma unroll
            for (int t = 1; t >= 0; --t) { const int n = 2 * ks + t;
                const float g0 = Gs[t], p = __builtin_bit_cast(float, __builtin_amdgcn_ds_bpermute(bp16, __builtin_bit_cast(int, g0))), tt = g0 + p;
                const float q = __builtin_bit_cast(float, __builtin_amdgcn_ds_bpermute(bp32, __builtin_bit_cast(int, tt)));
                const float Tn = tt + q, sfx = ((fq & 1) ? 0.f : p) + ((fq < 2) ? q : 0.f);
                const float b0 = base + sfx;
                const float lt3 = b0, lt2 = b0 + l1[t][3], lt1 = lt2 + l1[t][2], lt0 = lt1 + l1[t][1];
                float w0 = __builtin_amdgcn_exp2f(z[t][0] + lt0), w1 = __builtin_amdgcn_exp2f(z[t][1] + lt1), w2 = __builtin_amdgcn_exp2f(z[t][2] + lt2), w3 = __builtin_amdgcn_exp2f(z[t][3] + lt3);
                if (DIAGB) { const int kb = 16 * n + 4 * fq; w0 = (kb + 0 < lim) ? w0 : 0.f; w1 = (kb + 1 < lim) ? w1 : 0.f; w2 = (kb + 2 < lim) ? w2 : 0.f; w3 = (kb + 3 < lim) ? w3 : 0.f; }
                pk[t][0] = cvt_pk_bf16(w0, w1); pk[t][1] = cvt_pk_bf16(w2, w3);
                base += Tn; }
            const u32x4 bwv = (u32x4){pk[0][0], pk[0][1], pk[1][0], pk[1][1]};
            const bf16x8 bw = __builtin_bit_cast(bf16x8, bwv);
#pragma unroll
            for (int nt = 0; nt < 4; ++nt) { const LAS unsigned char* vp = ldsV + (16 * nt + fr) * 272 + (32 * ks + 4 * fq) * 2;
                const s16x4 lo = *(const LAS s16x4*)vp, hi = *(const LAS s16x4*)(vp + 32);
                const bf16x8 a = __builtin_shufflevector(lo, hi, 0, 1, 2, 3, 4, 5, 6, 7);
                oacc[nt] = __builtin_amdgcn_mfma_f32_16x16x32_bf16(a, bw, oacc[nt], 0, 0, 0); }
            if ((ks & 1) == 0) done = __all(base <= -150.1f) != 0;
        }
    }
    log_rest = base;
    return done;
}

__device__ __forceinline__ void attn_phase(LAS unsigned char* lds, const bf16_t* Q, const bf16_t* Kb, const bf16_t* Vt, bf16_t* O, int G, int c, int tid) {
    const int w = __builtin_amdgcn_readfirstlane(tid >> 6), lane = tid & 63, fr = lane & 15, fq = lane >> 4;
    const int bp16 = (lane ^ 16) << 2, bp32 = (lane ^ 32) << 2;
    LAS unsigned char* ldsK = lds; LAS unsigned char* ldsV = lds + 18432; volatile LAS int* flags = (volatile LAS int*)(lds + 35840);
    for (int u = c; u < 2048; u += G) {
        const int h = u & 15, qb = u >> 4, ql = 16 * w + fr;
        const size_t qrow = (size_t)qb * 128 + ql;
        bf16x8 qf[2];
#pragma unroll
        for (int ks = 0; ks < 2; ++ks) qf[ks] = *(const bf16x8*)(Q + qrow * D + h * 64 + 32 * ks + 8 * fq);
        f32x4 oacc[4];
#pragma unroll
        for (int i = 0; i < 4; ++i) oacc[i] = (f32x4){0.f, 0.f, 0.f, 0.f};
        float log_rest = 0.f; int mydone = 0;
        const int skey0 = tid >> 3, sch0 = tid & 7, sd0 = tid >> 4, sch1 = tid & 15;
        const bf16_t* kp = Kb + (size_t)skey0 * D + h * 64 + sch0 * 8;
        const bf16_t* vp0 = Vt + (size_t)(h * 64 + sd0) * L + sch1 * 8;
        u32x4 pk0 = *(const u32x4*)(kp + (size_t)128 * qb * D), pk1 = *(const u32x4*)(kp + (size_t)(128 * qb + 64) * D);
        u32x4 pv0 = *(const u32x4*)(vp0 + 128 * qb), pv1 = *(const u32x4*)(vp0 + (size_t)32 * L + 128 * qb);
        for (int j = qb; j >= 0; --j) {
            __syncthreads();
            if (j < qb) { int all = 1;
#pragma unroll
                for (int i = 0; i < 8; ++i) all &= flags[i];
                if (all && !DIAG_NOEXIT) break; }
            *(LAS u32x4*)(ldsK + skey0 * 144 + sch0 * 16) = pk0; *(LAS u32x4*)(ldsK + (skey0 + 64) * 144 + sch0 * 16) = pk1;
            *(LAS u32x4*)(ldsV + sd0 * 272 + sch1 * 16) = pv0;   *(LAS u32x4*)(ldsV + (sd0 + 32) * 272 + sch1 * 16) = pv1;
            __syncthreads();
            if (j > 0) { const int jn = j - 1;
                pk0 = *(const u32x4*)(kp + (size_t)128 * jn * D); pk1 = *(const u32x4*)(kp + (size_t)(128 * jn + 64) * D);
                pv0 = *(const u32x4*)(vp0 + 128 * jn); pv1 = *(const u32x4*)(vp0 + (size_t)32 * L + 128 * jn); }
            if (!mydone) {
            bool dn;
            if (j == qb) dn = attn_block<true>(ldsK, ldsV, qf, oacc, log_rest, w, fr, fq, ql, bp16, bp32); else dn = attn_block<false>(ldsK, ldsV, qf, oacc, log_rest, w, fr, fq, ql, bp16, bp32);
            mydone = dn ? 1 : 0;
            if (lane == 0) flags[w] = mydone;
            }
        }
#pragma unroll
        for (int nt = 0; nt < 4; ++nt) { u32x2 o; o.x = cvt_pk_bf16(oacc[nt][0], oacc[nt][1]); o.y = cvt_pk_bf16(oacc[nt][2], oacc[nt][3]);
            *(u32x2*)(O + qrow * D + h * 64 + 16 * nt + 4 * fq) = o; }
    }
}


#define XB_TMO      128
#define XB_XCNT(j)  (256  + 64 * (j))
#define XB_XSUB(j)  (1280 + 64 * (j))
#define XB_XGEN(j)  (2304 + 64 * (j))
#define XB_TOP      3328
#define XB_TOPGEN   3392
#define XCD_BAR_WORDS 3456
#define XB_SPIN_CAP (1u << 18)
__device__ __forceinline__ unsigned xb_ld(unsigned* p)              { return __hip_atomic_load(p, __ATOMIC_RELAXED, __HIP_MEMORY_SCOPE_AGENT); }
__device__ __forceinline__ unsigned xb_add(unsigned* p, unsigned v) { return __hip_atomic_fetch_add(p, v, __ATOMIC_RELAXED, __HIP_MEMORY_SCOPE_AGENT); }
__device__ __forceinline__ unsigned xb_xcc_id() { return (unsigned)__builtin_amdgcn_s_getreg((3 << 11) | 20) & 0xFu; }
#define XB_SPIN(cond, bar) do { unsigned _sp = 0; while (cond) { __builtin_amdgcn_s_sleep(1); \
    if ((++_sp & 255u) == 0u) { if (xb_ld(&(bar)[XB_TMO])) break; if (_sp > XB_SPIN_CAP) { atomicAdd(&(bar)[XB_TMO], 1u); break; } } } } while (0)
struct XcdBarrier { unsigned* bar; unsigned x; volatile LAS unsigned* st; };
__device__ __forceinline__ XcdBarrier xcd_barrier_post(unsigned* bar, volatile LAS unsigned* st) {
    XcdBarrier b; b.bar = bar; b.x = xb_xcc_id(); b.st = st;
    if (threadIdx.x == 0) (void)xb_add(&bar[XB_XCNT(b.x)], 1u);
    return b;
}
__device__ __forceinline__ void xcd_barrier_complete(unsigned* bar, unsigned x, unsigned& nloc, unsigned& nx) {
    const unsigned G = gridDim.x * gridDim.y * gridDim.z;
    unsigned sum, cnt, mine, sp = 0u;
    for (;;) {
        sum = 0u; cnt = 0u; mine = 0u;
#pragma unroll
        for (unsigned j = 0; j < 16; ++j) { const unsigned c = xb_ld(&bar[XB_XCNT(j)]); sum += c; cnt += (c > 0u) ? 1u : 0u; mine = (j == x) ? c : mine; }
        if (sum == G) break;
        __builtin_amdgcn_s_sleep(1);
        if ((++sp & 255u) == 0u) { if (xb_ld(&bar[XB_TMO])) break; if (sp > XB_SPIN_CAP) { atomicAdd(&bar[XB_TMO], 1u); break; } }
    }
    nloc = mine > 0u ? mine : 1u; nx = cnt > 0u ? cnt : 1u;
}
__device__ __forceinline__ void xcd_barrier(const XcdBarrier& b) {
    asm volatile("s_waitcnt vmcnt(0)" ::: "memory");
    __syncthreads();
    if (threadIdx.x == 0) {
        unsigned* bar = b.bar;
        __builtin_amdgcn_s_waitcnt(0);
        unsigned nloc = b.st[0], nx = b.st[1];
        if (nloc == 0u) { xcd_barrier_complete(bar, b.x, nloc, nx); b.st[0] = nloc; b.st[1] = nx; }
        const unsigned old = xb_add(&bar[XB_XSUB(b.x)], 1u);
        const unsigned gen = old / nloc;
        if (old + 1u == (gen + 1u) * nloc) {
            __builtin_amdgcn_fence(__ATOMIC_RELEASE, "agent");
            asm volatile("s_waitcnt vmcnt(0)" ::: "memory");
            const unsigned og = xb_add(&bar[XB_TOP], 1u);
            const unsigned tg = og / nx;
            if (og + 1u == (tg + 1u) * nx) xb_add(&bar[XB_TOPGEN], 1u);
            else XB_SPIN(xb_ld(&bar[XB_TOPGEN]) == tg, bar);
            __builtin_amdgcn_fence(__ATOMIC_ACQUIRE, "agent");
            xb_add(&bar[XB_XGEN(b.x)], 1u);
            asm volatile("s_waitcnt vmcnt(0)" ::: "memory");
        } else {
            XB_SPIN(xb_ld(&bar[XB_XGEN(b.x)]) == gen, bar);
            __builtin_amdgcn_fence(__ATOMIC_ACQUIRE, "agent");
            asm volatile("s_waitcnt vmcnt(0)" ::: "memory");
        }
    }
    __syncthreads();
}

__device__ __forceinline__ float bf1(const bf16_t* p) { return __uint_as_float(((unsigned)*p) << 16); }
__device__ __forceinline__ float wave_max(float v) {
#pragma unroll
    for (int o = 1; o < 64; o <<= 1) v = fmaxf(v, __shfl_xor(v, o));
    return v;
}
__device__ __forceinline__ void diag_s5(const S5In& in, const float* dskip, const bf16_t* Aext, const bf16_t* Y, float* res, int tid) {
    if (tid < 64) {
        const int p = tid, g = 5, lg = g;
        const double dtd = exp((double)in.log_dt[lg]), are = (double)in.a_re[lg * 64 + p], aim = (double)in.a_im[lg * 64 + p];
        double lr, li; cpow_d(are, aim, dtd, 1.0, lr, li);
        const double nr = lr - 1.0, ni = li, den = are * are + aim * aim;
        const double fr_ = (nr * are + ni * aim) / den, fi_ = (ni * are - nr * aim) / den;
        const f32x2 lam = (f32x2){(float)lr, (float)li};
        f32x2 bb[16], cc[16]; float dd[16];
#pragma unroll
        for (int c = 0; c < 16; ++c) { const double br = (double)in.b_re[(size_t)(lg * 64 + p) * 16 + c], bi = (double)in.b_im[(size_t)(lg * 64 + p) * 16 + c];
            bb[c] = (f32x2){(float)(fr_ * br - fi_ * bi), (float)(fr_ * bi + fi_ * br)};
            cc[c] = (f32x2){in.c_re[(size_t)(lg * 16 + c) * 64 + p], in.c_im[(size_t)(lg * 16 + c) * 64 + p]}; dd[c] = dskip[g * 16 + c]; }
        f32x2 x = (f32x2){0.f, 0.f}; float maxd = 0.f, maxa = 0.f;
        for (int t = 0; t < 2048; ++t) {
            const bf16_t* up = Aext + ((size_t)(g * NCH + (t >> 4)) * AK + (t & 15) * 16);
            const u32x4 u0 = *(const u32x4*)up, u1 = *((const u32x4*)up + 1);
            float uu[16] = {bf_lo(u0.x), bf_hi(u0.x), bf_lo(u0.y), bf_hi(u0.y), bf_lo(u0.z), bf_hi(u0.z), bf_lo(u0.w), bf_hi(u0.w), bf_lo(u1.x), bf_hi(u1.x), bf_lo(u1.y), bf_hi(u1.y), bf_lo(u1.z), bf_hi(u1.z), bf_lo(u1.w), bf_hi(u1.w)};
            f32x2 bu = (f32x2){0.f, 0.f};
#pragma unroll
            for (int c = 0; c < 16; ++c) bu += bb[c] * uu[c];
            x = cmul(lam, x) + bu;
#pragma unroll
            for (int c = 0; c < 16; ++c) { float yc = cc[c].x * x.x - cc[c].y * x.y; yc = wave_sum(yc); yc += dd[c] * uu[c];
                const float tt = 1.5957691216057308f * (yc + 0.044715f * yc * yc * yc); yc = yc / (1.0f + expf(-tt));
                const float got = bf1(Y + (size_t)t * D + g * 16 + c); maxd = fmaxf(maxd, fabsf(yc - got)); maxa = fmaxf(maxa, fabsf(yc)); }
        }
        if (p == 0) res[0] = maxd / maxa;
    }
}
__device__ __forceinline__ void diag_attn(const bf16_t* Q, const bf16_t* Kb, const bf16_t* Vt, const bf16_t* O, float* res, int tid) {
    const int w = tid >> 6, d = tid & 63;
    const int t = 40 * 128 + (w == 0 ? 0 : w == 1 ? 15 : w == 2 ? 16 : w == 3 ? 64 : w == 4 ? 100 : w == 5 ? 120 : w == 6 ? 125 : 127), h = 3;
    const float q = bf1(Q + (size_t)t * D + h * 64 + d);
    float acc = 0.f, o = 0.f; const int s_lo = t - 600 > 0 ? t - 600 : 0;
    for (int s = t - 1; s >= s_lo; --s) { const float z = wave_sum(q * bf1(Kb + (size_t)s * D + h * 64 + d)); const float sp = logf(1.0f + expf(-fabsf(z))), lb = fminf(z, 0.f) - sp;
        const float wgt = expf(lb + acc); acc += lb - z; o += wgt * bf1(Vt + (size_t)(h * 64 + d) * L + s); }
    const float got = bf1(O + (size_t)t * D + h * 64 + d);
    const float dd = wave_max(fabsf(o - got)), aa = wave_max(fabsf(o));
    if (d == 0) res[1 + w] = dd / aa;
}
__device__ __forceinline__ float digit_of(float err) { float dgt = -2.0f * log10f(fmaxf(err, 1e-6f)); return fminf(fmaxf(rintf(dgt), 0.f), 9.f); }

struct Args { const float* in[22]; float* out; unsigned char* ws; int ph_lo, ph_hi; };

__global__ void __launch_bounds__(512, 2) mk_fwd(Args a) {
    extern __shared__ __attribute__((aligned(16))) unsigned char lds_raw[];
    LAS unsigned char* lds = (LAS unsigned char*)lds_raw;
    cg::grid_group grid = cg::this_grid();
    volatile LAS unsigned* xst = (volatile LAS unsigned*)(lds + 131072 + 64);
    if (threadIdx.x < 2) xst[threadIdx.x] = 0u;
    __syncthreads();
    const XcdBarrier xbar = xcd_barrier_post((unsigned*)a.ws, xst);
    const int G0 = gridDim.x, c0 = blockIdx.x;
    typedef const __attribute__((address_space(4))) Args* KArgs;
    const int lo = a.ph_lo, hi = a.ph_hi; (void)lo; (void)hi;
    int ph = 0; (void)ph;
#if DIAG == 3
    unsigned long long t0_ = __builtin_amdgcn_s_memrealtime(), tacc = 0; int cur_group = 0;
#define GRP(g) cur_group = (g);
#else
#define GRP(g)
#endif
#if MK_ONE_LAUNCH
#define PH_COND true
#define PH_SYNC(last) if (!(last)) { if (USE_CG_SYNC) grid.sync(); else xcd_barrier(xbar); }
#else
#define PH_COND (ph >= lo && ph < hi)
#define PH_SYNC(last)
#endif
#define PH_BEGIN if (PH_COND) { int tid = threadIdx.x; asm volatile("" : "+v"(tid)); int c = c0, G = G0; asm volatile("" : "+s"(c), "+s"(G)); const int NGW = G * 8; (void)NGW; const int lane = tid & 63, wave = __builtin_amdgcn_readfirstlane(tid >> 6), gw = c * 8 + wave; (void)lane; (void)gw; \
    KArgs ap = (KArgs)__builtin_amdgcn_kernarg_segment_ptr(); asm volatile("" : "+s"(ap)); unsigned char* ws = ap->ws; float* out = ap->out; const float* x = ap->in[0]; (void)out; (void)x; \
    bf16_t* WIN = (bf16_t*)(ws + WS_WIN); bf16_t* WOUT = (bf16_t*)(ws + WS_WOUT); bf16_t* WGLU = (bf16_t*)(ws + WS_WGLU); \
    bf16_t* WK = (bf16_t*)(ws + WS_WK); bf16_t* WV = (bf16_t*)(ws + WS_WV); bf16_t* WQ = (bf16_t*)(ws + WS_WQ); bf16_t* WO = (bf16_t*)(ws + WS_WO); \
    bf16_t* BT3 = (bf16_t*)(ws + WS_BT3); bf16_t* W1T = (bf16_t*)(ws + WS_W1T); float* SC = (float*)(ws + WS_SC); \
    bf16_t* AEXT = (bf16_t*)(ws + WS_AEXT); float* Sb = (float*)(ws + WS_S); bf16_t* ACT = (bf16_t*)(ws + WS_ACT); bf16_t* MIX = (bf16_t*)(ws + WS_MIX); \
    bf16_t* VT = (bf16_t*)(ws + WS_VT); bf16_t* KB = (bf16_t*)(ws + WS_KB); bf16_t* Yb = (bf16_t*)(ws + WS_Y); bf16_t* Qb = (bf16_t*)(ws + WS_Q); bf16_t* Ob = (bf16_t*)(ws + WS_O); bf16_t* HK = (bf16_t*)(ws + WS_HK); \
    (void)WIN; (void)WOUT; (void)WGLU; (void)WK; (void)WV; (void)WQ; (void)WO; (void)BT3; (void)W1T; (void)SC; (void)AEXT; (void)Sb; (void)ACT; (void)MIX; (void)VT; (void)KB; (void)Yb; (void)Qb; (void)Ob; (void)HK;
#if DIAG == 3
#define PH_STAMP { const unsigned long long t1_ = __builtin_amdgcn_s_memrealtime(); if (cur_group == DIAG_GROUP) tacc += t1_ - t0_; t0_ = t1_; }
#else
#define PH_STAMP
#endif
#define PH_END   PH_SYNC(false) PH_STAMP } ++ph;
#define PH_END_CG   if (lo == 0x7fffffff) grid.sync();   xcd_barrier(xbar); } ++ph;
#define PH_END_LAST(last)   PH_SYNC(last) PH_STAMP } ++ph;

    DUPFOR(0) PH_BEGIN
        if (c < 128) { S5In in{ap->in[7], ap->in[8], ap->in[9], ap->in[10], ap->in[11], ap->in[12], ap->in[13]}; s5_precompute(lds, in, c >> 6, c & 63, BT3, W1T, SC, tid); }
        LAS unsigned short* scr = (LAS unsigned short*)(lds + wave * 16384);
        constexpr int I_IN = 16 * 88, I_OUT = 44 * 16, I_GLU = 16 * 32, I_SQ = 16 * 16;
        constexpr int NITEMS = 4 * I_IN + I_OUT + 2 * I_GLU + 6 * I_SQ;
        for (int it = gw; it < NITEMS; it += NGW) {
            int r = it;
            if (r < 4 * I_IN) { const int l = r / I_IN; transpose_item(ap->in[5] + (size_t)l * D * 2 * DFF, D, 2 * DFF, WIN + (size_t)l * 2 * DFF * D, DFF, scr, r % I_IN, lane); continue; } r -= 4 * I_IN;
            if (r < I_OUT) { transpose_item(ap->in[6], DFF, D, WOUT, 0, scr, r, lane); continue; } r -= I_OUT;
            if (r < 2 * I_GLU) { const int l = r / I_GLU; transpose_item(ap->in[15] + (size_t)l * D * 2 * D, D, 2 * D, WGLU + (size_t)l * 2 * D * D, D, scr, r % I_GLU, lane); continue; } r -= 2 * I_GLU;
            const int wsel = r / I_SQ; r %= I_SQ;
            const float* src = wsel == 0 ? ap->in[18] : wsel == 1 ? ap->in[19] : wsel < 4 ? ap->in[20] + (size_t)(wsel - 2) * D * D : ap->in[21] + (size_t)(wsel - 4) * D * D;
            bf16_t* dst = wsel == 0 ? WK : wsel == 1 ? WV : wsel < 4 ? WQ + (size_t)(wsel - 2) * D * D : WO + (size_t)(wsel - 4) * D * D;
            transpose_item(src, D, D, dst, 0, scr, r, lane);
        }
        rowpass(gw, NGW, lane, x, nullptr, 0, 0, nullptr, nullptr, AEXT, ap->in[1], 1, nullptr, nullptr);
    PH_END_CG

#if EXTRA_SYNCS
    for (int i_ = 0; i_ < EXTRA_SYNCS; ++i_) xcd_barrier(xbar);
#endif
    for (int l = 0; l < 4; ++l) {
        if (l < 2) {
            PH_BEGIN
                { pg8::Gemm g{AEXT, W1T + (size_t)l * NG * 128 * 256, NCH, 256, 256, AK, 256, NG, (unsigned)NCH * AK, 128u * 256u};
                  pg8::EpiS5State E{}; pg8::gemm_phase(lds, g, E, G, c, tid); }
                __syncthreads();
                s5_scan(lds, Sb, SC, AEXT, (float*)(ws + WS_XCH + 3 * MiB), (unsigned*)(ws + WS_CNT2), l, G, c, tid);
                { pg8::Gemm g{AEXT, BT3 + (size_t)l * NG * 256 * AK, NCH, 256, AK, AK, AK, NG, (unsigned)NCH * AK, 256u * AK};
                  pg8::EpiS5Out E{AEXT, ap->in[14] + (size_t)l * NG * 16, Yb}; pg8::gemm_phase(lds, g, E, G, c, tid); }
            PH_END
            DUPFOR(2) PH_BEGIN
#if DIAG == 1
                if (l == 0) { if (c == 0) { S5In in{ap->in[7], ap->in[8], ap->in[9], ap->in[10], ap->in[11], ap->in[12], ap->in[13]}; diag_s5(in, ap->in[14], AEXT, Yb, (float*)ws, tid); if (tid == 0) out[0] = (digit_of(((float*)ws)[0]) + 1.f) * 10000.f; } return; }
#endif
                pg8::Gemm g{Yb, WGLU + (size_t)l * 2 * D * D, L, 2 * D, D, D, D, 1, 0, 0};
                pg8::EpiGLU E{MIX, D, ap->in[16] + (size_t)l * 2 * D, D}; pg8::gemm_phase(lds, g, E, G, c, tid);
            PH_END
        } else {
            const int b = l - 2;
            DUPFOR(2) PH_BEGIN
                if (l == 2) {
                    { pg8::Gemm g{HK, WK, L, D, D, D, D, 1, 0, 0}; pg8::EpiPlain E{KB, D, 1.0f}; pg8::gemm_phase(lds, g, E, G, c, tid); }
                    { pg8::Gemm g{WV, HK, D, L, D, D, D, 1, 0, 0}; pg8::EpiPlain E{VT, L, 1.0f}; pg8::gemm_phase(lds, g, E, G, c, tid); }
                }
                { pg8::Gemm g{MIX, WQ + (size_t)b * D * D, L, D, D, D, D, 1, 0, 0}; pg8::EpiPlain E{Qb, D, 0.18033688011112042f  }; pg8::gemm_phase(lds, g, E, G, c, tid); }
#if DIAG == 2
                grid.sync(); __threadfence(); grid.sync();
#endif
            PH_END
            DUPFOR(3) PH_BEGIN
                attn_phase(lds, Qb, KB, VT, Ob, G, c, tid);
            PH_END
            DUPFOR(2) PH_BEGIN
#if DIAG == 2
                if (l == 2) { if (c == 1) { diag_attn(Qb, KB, VT, Ob, (float*)ws, tid); __syncthreads(); if (tid == 0) { const float* res = (const float*)ws; int lo4 = 0, hi4 = 0; for (int i = 0; i < 4; ++i) { if (res[1 + i] > 0.1f) lo4 |= 1 << i; if (res[5 + i] > 0.1f) hi4 |= 1 << i; } float V = (10.f + (float)lo4) * 1000.f; for (int i = 0; i < hi4; ++i) V *= 10.f; out[0] = V; } } return; }
#endif
                pg8::Gemm g{Ob, WO + (size_t)b * D * D, L, D, D, D, D, 1, 0, 0};
                bf16_t* hslot = (bf16_t*)out + D;
                pg8::EpiResNorm E{hslot, 2 * D, l == 3 ? KB : hslot, l == 3 ? D : 2 * D, nullptr, ap->in[2] + l * D, MIX, ap->in[3] + l * D, 0, nullptr, nullptr, (float*)(ws + WS_XCH), (unsigned*)(ws + WS_CNT), b};
                pg8::gemm_phase(lds, g, E, G, c, tid);
            PH_END
        }
        if (l < 2) {
        DUPFOR(4) PH_BEGIN
            rowpass(gw, NGW, lane, x, out, l == 0 ? 0 : 1, 1, MIX, ap->in[2] + l * D, MIX, ap->in[3] + l * D, 0, nullptr, nullptr);
        PH_END
        }
        DUPFOR(5) PH_BEGIN
            pg8::Gemm g{MIX, WIN + (size_t)l * 2 * DFF * D, L, 2 * DFF, D, D, D, 1, 0, 0};
            pg8::EpiSwiGLU E{ACT, DFF}; pg8::gemm_phase(lds, g, E, G, c, tid);
            if (l < 3 && c >= G / 2) {
                LAS unsigned short* scr = (LAS unsigned short*)(lds + wave * 16384);
                constexpr int I_OUT = 44 * 16;
                const int hw = (c - G / 2) * 8 + wave, NHW = (G - G / 2) * 8, ln = l + 1;
                for (int it = hw; it < I_OUT; it += NHW) transpose_item(ap->in[6] + (size_t)ln * DFF * D, DFF, D, WOUT + (size_t)ln * D * DFF, 0, scr, it, lane);
            }
        PH_END
        PH_BEGIN
            pg8::Gemm g{ACT, WOUT + (size_t)l * D * DFF, L, D, DFF, DFF, DFF, 1, 0, 0};
            bf16_t* hslot = (bf16_t*)out + D;
            const bf16_t* hin = l == 3 ? KB : hslot; const int hin_pitch = l == 3 ? D : 2 * D;
            bf16_t* o1 = l == 0 ? AEXT : l == 3 ? nullptr : MIX; const float* gg1 = ap->in[1] + (l < 3 ? l + 1 : 0) * D;
            pg8::EpiResNorm E{hin, hin_pitch, hslot, 2 * D, l == 3 ? out : nullptr, ap->in[4] + l * D, o1, gg1, l == 0 ? 1 : 0, l == 1 ? HK : nullptr, ap->in[17], (float*)(ws + WS_XCH), (unsigned*)(ws + WS_CNT), 2 + l};
            pg8::gemm_phase(lds, g, E, G, c, tid);
        PH_END_LAST(DIAG != 3 && l == 3)
    }
#if DIAG == 3
    grid.sync();
    if (c0 == 0 && threadIdx.x == 0) a.out[0] = (float)tacc * 10.0f;
#endif
#undef PH_BEGIN
#undef PH_END
#undef PH_END_CG
#undef PH_END_LAST
}
constexpr int N_PHASES = 1 + 2 * 8 + 2 * 7;

extern "C" void kernel_launch(void* const* d_in, const int* in_sizes, int n_in, void* d_out, int out_size, void* d_ws, size_t ws_size, hipStream_t stream) {
    static int grid = 0;
    if (grid == 0) {
        if (n_in != 22 || in_sizes[0] != L * D || out_size != L * D || ws_size < WS_END) { fprintf(stderr, "kernel_launch: unexpected shapes (n_in %d in0 %d out %d ws %zu)\n", n_in, n_in > 0 ? in_sizes[0] : -1, out_size, ws_size); grid = -1; return; }
        int dev = 0, cus = 0, per_cu = 0;
        hipGetDevice(&dev); hipDeviceGetAttribute(&cus, hipDeviceAttributeMultiprocessorCount, dev);
        if (hipFuncSetAttribute((const void*)mk_fwd, hipFuncAttributeMaxDynamicSharedMemorySize, LDS_BYTES) != hipSuccess) { fprintf(stderr, "kernel_launch: hipFuncSetAttribute failed\n"); grid = -1; return; }
        if (hipOccupancyMaxActiveBlocksPerMultiprocessor(&per_cu, (const void*)mk_fwd, 512, LDS_BYTES) != hipSuccess || per_cu < 1) { fprintf(stderr, "kernel_launch: occupancy query says %d blocks/CU\n", per_cu); grid = -1; return; }
        if (cus != 256) { fprintf(stderr, "kernel_launch: built for a 256-CU device (one 256x256 unit per workgroup in the fused-epilogue phases); found %d CUs, nothing launched\n", cus); grid = -1; return; }
        grid = cus;
    }
    if (grid < 0) return;
    if (hipMemsetAsync(d_ws, 0, CTL_ZERO_BYTES, stream) != hipSuccess) { fprintf(stderr, "kernel_launch: memset failed\n"); return; }
    Args a{};
    for (int i = 0; i < 22; ++i) a.in[i] = (const float*)d_in[i];
    a.out = (float*)d_out; a.ws = (unsigned char*)d_ws;
#if MK_ONE_LAUNCH
    a.ph_lo = 0; a.ph_hi = N_PHASES;
    void* args[] = {&a};
    hipError_t e = hipLaunchCooperativeKernel((const void*)mk_fwd, dim3(grid), dim3(512), args, LDS_BYTES, stream);
    if (e != hipSuccess) fprintf(stderr, "cooperative launch failed: %s (grid %d)\n", hipGetErrorString(e), grid);
#else
    for (int p = 0; p < N_PHASES; ++p) { a.ph_lo = p; a.ph_hi = p + 1; hipLaunchKernelGGL(mk_fwd, dim3(grid), dim3(512), LDS_BYTES, stream, a); }
#endif
}
```

```cpp
#include <hip/hip_runtime.h>
#include <hip/hip_cooperative_groups.h>
#include <cstdio>
#include <cstdint>
namespace cg = cooperative_groups;

#ifndef DIAG
#define DIAG 0
#endif
#ifndef USE_CG_SYNC
#define USE_CG_SYNC 0
#endif
#ifndef EXTRA_SYNCS
#define EXTRA_SYNCS 0
#endif
#ifndef DUP_GROUP
#define DUP_GROUP -1
#endif
#define DUPFOR(k) for (int rep_ = 0; rep_ < ((DUP_GROUP == (k)) ? 2 : 1); ++rep_)
#ifndef DIAG_GROUP
#define DIAG_GROUP 2
#endif
#ifndef DIAG_NOEXIT
#define DIAG_NOEXIT 0
#endif
#ifndef DIAG_NIB
#define DIAG_NIB 0
#endif
#ifndef MK_ONE_LAUNCH
#define MK_ONE_LAUNCH 1
#endif

#define LAS __attribute__((address_space(3)))
typedef unsigned short bf16_t;
typedef short bf16x8 __attribute__((ext_vector_type(8)));
typedef short s16x4 __attribute__((ext_vector_type(4)));
typedef float f32x4 __attribute__((ext_vector_type(4)));
typedef float f32x2 __attribute__((ext_vector_type(2)));
typedef unsigned u32x4 __attribute__((ext_vector_type(4)));
typedef unsigned u32x2 __attribute__((ext_vector_type(2)));

constexpr int L = 16384, D = 1024, DFF = 2816, NG = 64, NCH = 1024, AK = 384;
constexpr float EPS = 1e-6f;
constexpr size_t MiB = 1u << 20;
constexpr size_t WS_WIN = 1 * MiB, WS_WOUT = 45 * MiB, WS_WGLU = 67 * MiB, WS_WK = 75 * MiB, WS_WV = 77 * MiB, WS_WQ = 79 * MiB, WS_WO = 83 * MiB;
constexpr size_t WS_BT3 = 87 * MiB, WS_W1T = 111 * MiB, WS_SC = 120 * MiB, WS_AEXT = 121 * MiB, WS_S = 169 * MiB, WS_ACT = 201 * MiB, WS_MIX = 289 * MiB, WS_XCH = 321 * MiB, WS_END = 325 * MiB;
constexpr size_t WS_VT = WS_AEXT, WS_KB = WS_S, WS_Y = WS_ACT, WS_Q = WS_ACT, WS_O = WS_ACT + 32 * MiB, WS_HK = WS_BT3;
constexpr int LDS_BYTES = 147456;
constexpr size_t WS_CNT = 65536, WS_CNT2 = 320 * 1024, CTL_ZERO_BYTES = 512 * 1024;

typedef __bf16 bf16x2_t __attribute__((ext_vector_type(2)));
__device__ __forceinline__ unsigned cvt_pk_bf16(float lo, float hi) { const f32x2 v = {lo, hi}; const bf16x2_t b = __builtin_convertvector(v, bf16x2_t); return __builtin_bit_cast(unsigned, b); }
__device__ __forceinline__ float bf_lo(unsigned w) { return __uint_as_float(w << 16); }
__device__ __forceinline__ float bf_hi(unsigned w) { return __uint_as_float(w & 0xffff0000u); }
__device__ __forceinline__ float wave_sum(float v) {
#pragma unroll
    for (int o = 1; o < 64; o <<= 1) v += __shfl_xor(v, o);
    return v;
}
#define LDS_WAIT() asm volatile("s_waitcnt lgkmcnt(0)" ::: "memory")

namespace pg8 {
constexpr int BM = 256, BK = 64, HALF = 128, HTB = HALF * BK * 2, NXCD = 8, WGM = 8;
__device__ __forceinline__ int lds_byte(int r, int c) { const int st = (r >> 4) * 2 + (c >> 5), rr = r & 15, cc = c & 31, ob = rr * 64 + cc * 2; return st * 1024 + (ob ^ (((ob >> 9) & 1) << 5)); }
__device__ __forceinline__ void stage_rc(int b, int& R, int& C) { const int st = b / 1024, sb = b % 1024, swz = sb ^ (((sb >> 9) & 1) << 5); R = (st >> 1) * 16 + swz / 64; C = (st & 1) * 32 + (swz % 64) / 2; }

__device__ __forceinline__ int perm32(int rho) { const int n = rho >> 4, i = rho & 15; return 8 * (i >> 2) + 4 * n + (i & 3); }
template <class T, class = void> struct epi_perm { static constexpr bool value = false; };
template <class T> struct epi_perm<T, decltype((void)T::PERM)> { static constexpr bool value = T::PERM; };
struct Unit { int pm, pn, b; };
struct Gemm { const bf16_t* A; const bf16_t* Bt; int M, N, K, lda, ldb, batch; unsigned bsA, bsB; };
struct Order {
    int nM, nN, per, total, G, c;
    __device__ __forceinline__ void init(int M, int N, int batch, int G_, int c_) { nM = M / BM; nN = N / BM; per = nM * nN; total = per * batch; G = G_; c = c_; }
    __device__ __forceinline__ bool next(int i, Unit& u) const {
        const int Lx = i * G + c; if (Lx >= total) return false;
        if (per == 4 && G == 256 && total == 256) { u.b = (c & 7) * 8 + (c >> 5); u.pm = (c >> 3) & 3; u.pn = 0; return true; }
        u.b = Lx / per; int wgid = Lx - u.b * per;
        { const int q = per / NXCD, r = per % NXCD, xcd = wgid % NXCD, off = wgid / NXCD; wgid = (xcd < r ? xcd * (q + 1) : r * (q + 1) + (xcd - r) * q) + off; }
        const int nig = WGM * nN, gid = wgid / nig, fm = gid * WGM, gsz = (nM - fm) < WGM ? (nM - fm) : WGM;
        u.pm = fm + ((wgid % nig) % gsz); u.pn = (wgid % nig) / gsz; return true;
    }
};

struct EpiPlain {
    static constexpr bool PERM = true;
    bf16_t* O; int ldc; float scale;
    __device__ __forceinline__ void operator()(const f32x4 (&acc)[2][2][4][2], const Unit& u, int wr, int wc, int fr, int fq) const {
        const int row0 = u.pm * BM + wr * 64 + fr, col0 = u.pn * BM + wc * 32 + 8 * fq;
#pragma unroll
        for (int ai = 0; ai < 2; ++ai)
#pragma unroll
            for (int m = 0; m < 4; ++m) { bf16_t* rowp = O + (size_t)(row0 + ai * HALF + m * 16) * ldc + col0;
#pragma unroll
                for (int bj = 0; bj < 2; ++bj) { const f32x4 v0 = acc[ai][bj][m][0] * scale, v1 = acc[ai][bj][m][1] * scale;
                    *(u32x4*)(rowp + bj * HALF) = (u32x4){cvt_pk_bf16(v0[0], v0[1]), cvt_pk_bf16(v0[2], v0[3]), cvt_pk_bf16(v1[0], v1[1]), cvt_pk_bf16(v1[2], v1[3])}; } }
    }
};
struct EpiSwiGLU {
    static constexpr bool PERM = true;
    bf16_t* O; int ldc;
    __device__ __forceinline__ void operator()(const f32x4 (&acc)[2][2][4][2], const Unit& u, int wr, int wc, int fr, int fq) const {
        const int row0 = u.pm * BM + wr * 64 + fr, col0 = u.pn * HALF + wc * 32 + 8 * fq;
#pragma unroll
        for (int ai = 0; ai < 2; ++ai)
#pragma unroll
            for (int m = 0; m < 4; ++m) { bf16_t* rowp = O + (size_t)(row0 + ai * HALF + m * 16) * ldc + col0; unsigned w[4];
#pragma unroll
                for (int n = 0; n < 2; ++n) { const f32x4 g = acc[ai][0][m][n], up = acc[ai][1][m][n]; f32x4 v;
#pragma unroll
                    for (int e = 0; e < 4; ++e) v[e] = g[e] * up[e] * __builtin_amdgcn_rcpf(1.0f + __expf(-g[e]));
                    w[2 * n] = cvt_pk_bf16(v[0], v[1]); w[2 * n + 1] = cvt_pk_bf16(v[2], v[3]); }
                *(u32x4*)rowp = (u32x4){w[0], w[1], w[2], w[3]}; }
    }
};
struct EpiGLU {
    static constexpr bool PERM = true;
    bf16_t* O; int ldc; const float* bias; int halfN;
    __device__ __forceinline__ void operator()(const f32x4 (&acc)[2][2][4][2], const Unit& u, int wr, int wc, int fr, int fq) const {
        const int row0 = u.pm * BM + wr * 64 + fr, col0 = u.pn * HALF + wc * 32 + 8 * fq;
        f32x4 bv[2], bg[2];
#pragma unroll
        for (int n = 0; n < 2; ++n) { bv[n] = *(const f32x4*)(bias + col0 + 4 * n); bg[n] = *(const f32x4*)(bias + halfN + col0 + 4 * n); }
#pragma unroll
        for (int ai = 0; ai < 2; ++ai)
#pragma unroll
            for (int m = 0; m < 4; ++m) { bf16_t* rowp = O + (size_t)(row0 + ai * HALF + m * 16) * ldc + col0; unsigned w[4];
#pragma unroll
                for (int n = 0; n < 2; ++n) { const f32x4 a = acc[ai][0][m][n] + bv[n], g = acc[ai][1][m][n] + bg[n]; f32x4 v;
#pragma unroll
                    for (int e = 0; e < 4; ++e) v[e] = a[e] * __builtin_amdgcn_rcpf(1.0f + __expf(-g[e]));
                    w[2 * n] = cvt_pk_bf16(v[0], v[1]); w[2 * n + 1] = cvt_pk_bf16(v[2], v[3]); }
                *(u32x4*)rowp = (u32x4){w[0], w[1], w[2], w[3]}; }
    }
};
struct EpiS5State {
    static constexpr bool AFTER_DRAIN = true;
    __device__ __forceinline__ void fused(const f32x4 (&acc)[2][2][4][2], const Unit& u, int wr, int wc, int fr, int fq, LAS unsigned char* lds, int wid, int lane) const {
        LAS float* St = (LAS float*)lds;
#pragma unroll
        for (int ai = 0; ai < 2; ++ai)
#pragma unroll
            for (int m = 0; m < 4; ++m) { const int lr = ai * HALF + wr * 64 + m * 16 + fr;
#pragma unroll
                for (int n = 0; n < 2; ++n) *(LAS f32x4*)(St + lr * 128 + wc * 32 + n * 16 + 4 * fq) = acc[ai][0][m][n]; }
    }
};
struct EpiS5Out {
    const bf16_t* Aext; const float* dskip; bf16_t* Y;
    __device__ __forceinline__ void operator()(const f32x4 (&acc)[2][2][4][2], const Unit& u, int wr, int wc, int fr, int fq) const {
        const int row0 = u.pm * BM + wr * 64 + fr;
        const f32x4 dv = *(const f32x4*)(dskip + u.b * 16 + 4 * fq);
#pragma unroll
        for (int ai = 0; ai < 2; ++ai)
#pragma unroll
            for (int m = 0; m < 4; ++m) { const int row = row0 + ai * HALF + m * 16; const bf16_t* up = Aext + ((size_t)u.b * NCH + row) * AK + wc * 32 + 4 * fq;
#pragma unroll
                for (int bj = 0; bj < 2; ++bj)
#pragma unroll
                    for (int n = 0; n < 2; ++n) { const u32x2 uu = *(const u32x2*)(up + bj * HALF + n * 16); const f32x4 a = acc[ai][bj][m][n];
                        f32x4 v; v[0] = a[0] + dv[0] * bf_lo(uu.x); v[1] = a[1] + dv[1] * bf_hi(uu.x); v[2] = a[2] + dv[2] * bf_lo(uu.y); v[3] = a[3] + dv[3] * bf_hi(uu.y);
#pragma unroll
                        for (int e = 0; e < 4; ++e) { const float x = v[e], t = 1.5957691216057308f * (x + 0.044715f * x * x * x); v[e] = x * __builtin_amdgcn_rcpf(1.0f + __expf(-t)); }
                        const int i = 8 * bj + 2 * wc + n; u32x2 w; w.x = cvt_pk_bf16(v[0], v[1]); w.y = cvt_pk_bf16(v[2], v[3]);
                        *(u32x2*)(Y + (size_t)(row * 16 + i) * D + u.b * 16 + 4 * fq) = w; } }
    }
};


struct EpiResNorm {
    static constexpr bool AFTER_DRAIN = true, PERM = true;
    const bf16_t* hin; int hin_pitch; bf16_t* hout; int hout_pitch; float* hout_f; const float* g_post;
    bf16_t* out1; const float* g1; int mode1; bf16_t* out2; const float* g2;
    float* xch; unsigned* cnt; int inst;
    __device__ __forceinline__ void xpublish(const float (&part)[2][4], const Unit& u, int wr, int wc, int fr, int fq, LAS unsigned char* lds, int wid, int lane, int ex) const {
        LAS float* P = (LAS float*)lds;
        const int tid = wid * 64 + lane;
#pragma unroll
        for (int ai = 0; ai < 2; ++ai)
#pragma unroll
            for (int m = 0; m < 4; ++m) { float sq = part[ai][m]; sq += __shfl_xor(sq, 16); sq += __shfl_xor(sq, 32); if (fq == 0) P[(ai * HALF + wr * 64 + m * 16 + fr) * 4 + wc] = sq; }
        asm volatile("s_waitcnt lgkmcnt(0)" ::: "memory"); __builtin_amdgcn_s_barrier(); asm volatile("" ::: "memory");
        float* slots = xch + ((size_t)((inst * 2 + ex) * 64 + u.pm) * 256) * 4; unsigned* cw = cnt + ((inst * 2 + ex) * 64 + u.pm) * 64;
        if (tid < 256) { const float tot = (P[tid * 4] + P[tid * 4 + 1]) + (P[tid * 4 + 2] + P[tid * 4 + 3]); __hip_atomic_store(slots + tid * 4 + u.pn, tot, __ATOMIC_RELAXED, __HIP_MEMORY_SCOPE_AGENT); }
        asm volatile("s_waitcnt vmcnt(0)" ::: "memory");
        if (wid < 4 && lane == 0) __hip_atomic_fetch_add(cw, 1u, __ATOMIC_RELAXED, __HIP_MEMORY_SCOPE_AGENT);
    }
    __device__ __forceinline__ void xwait(const Unit& u, LAS unsigned char* lds, int wid, int lane, int ex) const {
        LAS float* S = (LAS float*)(lds + 4096);
        const int tid = wid * 64 + lane;
        float* slots = xch + ((size_t)((inst * 2 + ex) * 64 + u.pm) * 256) * 4; unsigned* cw = cnt + ((inst * 2 + ex) * 64 + u.pm) * 64;
        if (wid == 0) { unsigned sp = 0;
            while ((unsigned)__builtin_amdgcn_readfirstlane(__hip_atomic_load(cw, __ATOMIC_RELAXED, __HIP_MEMORY_SCOPE_AGENT)) < 16u) { __builtin_amdgcn_s_sleep(1); if (++sp > (1u << 22)) break; }
            __builtin_amdgcn_fence(__ATOMIC_ACQUIRE, "agent"); }
        asm volatile("s_waitcnt lgkmcnt(0)" ::: "memory"); __builtin_amdgcn_s_barrier(); asm volatile("" ::: "memory");
        if (tid < 256) { float t4 = 0.f;
#pragma unroll
            for (int t = 0; t < 4; ++t) t4 += __hip_atomic_load(slots + tid * 4 + t, __ATOMIC_RELAXED, __HIP_MEMORY_SCOPE_AGENT);
            S[tid] = 1.0f / sqrtf(t4 * (1.0f / D) + EPS); }
        asm volatile("s_waitcnt lgkmcnt(0)" ::: "memory"); __builtin_amdgcn_s_barrier(); asm volatile("" ::: "memory");
    }
    __device__ __forceinline__ void fused(f32x4 (&acc)[2][2][4][2], const Unit& u, int wr, int wc, int fr, int fq, LAS unsigned char* lds, int wid, int lane) const {
        const LAS float* S = (const LAS float*)(lds + 4096);
        const int col0 = u.pn * BM + wc * 32 + 8 * fq;
        float part[2][4];
#pragma unroll
        for (int ai = 0; ai < 2; ++ai)
#pragma unroll
            for (int m = 0; m < 4; ++m) { float sq = 0.f;
#pragma unroll
                for (int bj = 0; bj < 2; ++bj)
#pragma unroll
                    for (int n = 0; n < 2; ++n) { const f32x4 a = acc[ai][bj][m][n]; sq += (a[0] * a[0] + a[1] * a[1]) + (a[2] * a[2] + a[3] * a[3]); }
                part[ai][m] = sq; }
        xpublish(part, u, wr, wc, fr, fq, lds, wid, lane, 0);
        u32x4 ht[2][4][2];
#pragma unroll
        for (int ai = 0; ai < 2; ++ai)
#pragma unroll
            for (int m = 0; m < 4; ++m)
#pragma unroll
                for (int bj = 0; bj < 2; ++bj) ht[ai][m][bj] = *(const u32x4*)(hin + ((size_t)u.pm * BM + ai * HALF + wr * 64 + m * 16 + fr) * hin_pitch + col0 + bj * HALF);
        f32x4 gp[2][2];
#pragma unroll
        for (int bj = 0; bj < 2; ++bj)
#pragma unroll
            for (int n = 0; n < 2; ++n) gp[bj][n] = *(const f32x4*)(g_post + col0 + bj * HALF + 4 * n);
        xwait(u, lds, wid, lane, 0);
#pragma unroll
        for (int ai = 0; ai < 2; ++ai)
#pragma unroll
            for (int m = 0; m < 4; ++m) { const int lr = ai * HALF + wr * 64 + m * 16 + fr; const size_t row = (size_t)u.pm * BM + lr; const float rs = S[lr]; float sq = 0.f;
#pragma unroll
                for (int bj = 0; bj < 2; ++bj) { const int col = col0 + bj * HALF; const u32x4 t = ht[ai][m][bj];
                    f32x4 h0 = (f32x4){bf_lo(t.x), bf_hi(t.x), bf_lo(t.y), bf_hi(t.y)} + acc[ai][bj][m][0] * rs * gp[bj][0];
                    f32x4 h1 = (f32x4){bf_lo(t.z), bf_hi(t.z), bf_lo(t.w), bf_hi(t.w)} + acc[ai][bj][m][1] * rs * gp[bj][1];
                    if (hout_f) { *(f32x4*)(hout_f + row * D + col) = h0; *(f32x4*)(hout_f + row * D + col + 4) = h1; }
                    else { const u32x4 w = (u32x4){cvt_pk_bf16(h0[0], h0[1]), cvt_pk_bf16(h0[2], h0[3]), cvt_pk_bf16(h1[0], h1[1]), cvt_pk_bf16(h1[2], h1[3])}; *(u32x4*)(hout + row * hout_pitch + col) = w;
                        h0 = (f32x4){bf_lo(w.x), bf_hi(w.x), bf_lo(w.y), bf_hi(w.y)}; h1 = (f32x4){bf_lo(w.z), bf_hi(w.z), bf_lo(w.w), bf_hi(w.w)}; }
                    acc[ai][bj][m][0] = h0; acc[ai][bj][m][1] = h1;
                    sq += ((h0[0] * h0[0] + h0[1] * h0[1]) + (h0[2] * h0[2] + h0[3] * h0[3])) + ((h1[0] * h1[0] + h1[1] * h1[1]) + (h1[2] * h1[2] + h1[3] * h1[3])); }
                part[ai][m] = sq; }
        if (!out1) return;
        xpublish(part, u, wr, wc, fr, fq, lds, wid, lane, 1);
        xwait(u, lds, wid, lane, 1);
#pragma unroll
        for (int bj = 0; bj < 2; ++bj)
#pragma unroll
            for (int n = 0; n < 2; ++n) gp[bj][n] = *(const f32x4*)(g1 + col0 + bj * HALF + 4 * n);
#pragma unroll
        for (int ai = 0; ai < 2; ++ai)
#pragma unroll
            for (int m = 0; m < 4; ++m) { const int lr = ai * HALF + wr * 64 + m * 16 + fr; const int row = u.pm * BM + lr; const float rs = S[lr];
#pragma unroll
                for (int bj = 0; bj < 2; ++bj) { const int col = col0 + bj * HALF; const f32x4 a0 = acc[ai][bj][m][0], a1 = acc[ai][bj][m][1]; const f32x4 o0 = a0 * rs * gp[bj][0], o1 = a1 * rs * gp[bj][1];
                    bf16_t* p = mode1 ? out1 + ((size_t)((col >> 4) * NCH + (row >> 4)) * AK + (row & 15) * 16 + (col & 15)) : out1 + (size_t)row * D + col;
                    *(u32x4*)p = (u32x4){cvt_pk_bf16(o0[0], o0[1]), cvt_pk_bf16(o0[2], o0[3]), cvt_pk_bf16(o1[0], o1[1]), cvt_pk_bf16(o1[2], o1[3])}; } }
        if (out2) {
#pragma unroll
            for (int bj = 0; bj < 2; ++bj)
#pragma unroll
                for (int n = 0; n < 2; ++n) gp[bj][n] = *(const f32x4*)(g2 + col0 + bj * HALF + 4 * n);
#pragma unroll
            for (int ai = 0; ai < 2; ++ai)
#pragma unroll
                for (int m = 0; m < 4; ++m) { const int lr = ai * HALF + wr * 64 + m * 16 + fr; const size_t row = (size_t)u.pm * BM + lr; const float rs = S[lr];
#pragma unroll
                    for (int bj = 0; bj < 2; ++bj) { const int col = col0 + bj * HALF; const f32x4 o0 = acc[ai][bj][m][0] * rs * gp[bj][0], o1 = acc[ai][bj][m][1] * rs * gp[bj][1];
                        *(u32x4*)(out2 + row * D + col) = (u32x4){cvt_pk_bf16(o0[0], o0[1]), cvt_pk_bf16(o0[2], o0[3]), cvt_pk_bf16(o1[0], o1[1]), cvt_pk_bf16(o1[2], o1[3])}; } }
        }
    }
};

template <class T, class = void> struct epi_after_drain { static constexpr bool value = false; };
template <class T> struct epi_after_drain<T, decltype((void)T::AFTER_DRAIN)> { static constexpr bool value = T::AFTER_DRAIN; };
template <class Epi>
__device__ __forceinline__ void gemm_phase(LAS unsigned char* lds, const Gemm g, const Epi& E, int G, int c, int tid) {
    const int wid = __builtin_amdgcn_readfirstlane(tid >> 6), lane = tid & 63, wr = wid >> 2, wc = wid & 3, fr = lane & 15, fq = lane >> 4;
    const int nt = g.K / BK;
    unsigned voffA[2], voffB[2];
#pragma unroll
    for (int i = 0; i < 2; ++i) { int R, C; stage_rc(tid * 16 + i * 8192, R, C); voffA[i] = (unsigned)(R * g.lda + C) * 2u; const int Rb = epi_perm<Epi>::value ? ((R & ~31) + perm32(R & 31)) : R; voffB[i] = (unsigned)(Rb * g.ldb + C) * 2u; }
    constexpr unsigned kstep = BK * 2;
    const unsigned hA = (unsigned)HALF * g.lda * 2, hB = (unsigned)HALF * g.ldb * 2, tA = 2 * hA, tB = 2 * hB;
    const unsigned ldsw = (unsigned)wid * 1024u;
    const int aoff = lds_byte(wr * 64 + fr, fq * 8), boff = lds_byte(wc * 32 + fr, fq * 8);
#define PG8_SA(b, h) (((b) * 2 + (h)) * HTB)
#define PG8_SB(b, h) ((4 + (b) * 2 + (h)) * HTB)
#define PG8_STAGE(bufoff, gbase, voff) do { _Pragma("unroll") for (int _i = 0; _i < 2; ++_i) \
        __builtin_amdgcn_global_load_lds((const unsigned*)((const char*)(gbase) + (voff)[_i]), (LAS unsigned*)(lds + (bufoff) + ldsw + _i * 8192), 16, 0, 0); } while (0)
#define PG8_LDA(dst, b, h) do { _Pragma("unroll") for (int m = 0; m < 4; ++m) _Pragma("unroll") for (int k = 0; k < 2; ++k) dst[m][k] = *(const LAS bf16x8*)(lds + PG8_SA(b, h) + aoff + m * 2048 + k * 1024); } while (0)
#define PG8_LDB(dst, b, h) do { _Pragma("unroll") for (int n = 0; n < 2; ++n) _Pragma("unroll") for (int k = 0; k < 2; ++k) dst[n][k] = *(const LAS bf16x8*)(lds + PG8_SB(b, h) + boff + n * 2048 + k * 1024); } while (0)
#define PG8_MMA(ai, bj, At, Bt) do { __builtin_amdgcn_s_setprio(1); _Pragma("unroll") for (int m = 0; m < 4; ++m) _Pragma("unroll") for (int n = 0; n < 2; ++n) _Pragma("unroll") for (int k = 0; k < 2; ++k) \
        acc[ai][bj][m][n] = __builtin_amdgcn_mfma_f32_16x16x32_bf16(Bt[n][k], At[m][k], acc[ai][bj][m][n], 0, 0, 0); __builtin_amdgcn_s_setprio(0); } while (0)
#define PG8_WAIT_V(n) asm volatile("s_waitcnt vmcnt(" #n ")" ::: "memory")
#define PG8_WAIT_L(n) asm volatile("s_waitcnt lgkmcnt(" #n ")" ::: "memory")
#define PG8_BAR __builtin_amdgcn_s_barrier()
#define PG8_SCHED __builtin_amdgcn_sched_barrier(0)
    Order S; S.init(g.M, g.N, g.batch, G, c);
    Unit cur, nxt; int ui = 0;
    if (!S.next(0, cur)) return;
    f32x4 acc[2][2][4][2];
#pragma unroll
    for (int a = 0; a < 2; ++a)
#pragma unroll
        for (int b = 0; b < 2; ++b)
#pragma unroll
            for (int m = 0; m < 4; ++m)
#pragma unroll
                for (int n = 0; n < 2; ++n) acc[a][b][m][n] = (f32x4){0.f, 0.f, 0.f, 0.f};
    bf16x8 At[4][2], B0[2][2], B1[2][2];
    const char* cA = (const char*)g.A + ((unsigned)cur.b * g.bsA * 2u + (unsigned)cur.pm * tA); const char* cB = (const char*)g.Bt + ((unsigned)cur.b * g.bsB * 2u + (unsigned)cur.pn * tB);
    PG8_STAGE(PG8_SB(0, 0), cB, voffB); PG8_STAGE(PG8_SB(0, 1), cB + hB, voffB); PG8_STAGE(PG8_SA(0, 0), cA, voffA); PG8_STAGE(PG8_SA(0, 1), cA + hA, voffA);
    if (wr == 1) PG8_BAR;
    PG8_WAIT_V(2); PG8_BAR;
    PG8_STAGE(PG8_SB(1, 0), cB + kstep, voffB); PG8_STAGE(PG8_SA(1, 0), cA + kstep, voffA); PG8_STAGE(PG8_SB(1, 1), cB + hB + kstep, voffB);
    PG8_WAIT_V(6); PG8_BAR;
    for (;;) {
        const bool has_next = S.next(ui + 1, nxt);
        const char* nA = has_next ? (const char*)g.A + ((unsigned)nxt.b * g.bsA * 2u + (unsigned)nxt.pm * tA) : cA; const char* nB = has_next ? (const char*)g.Bt + ((unsigned)nxt.b * g.bsB * 2u + (unsigned)nxt.pn * tB) : cB;
        for (int t = 0; t < nt; t += 2) {
            const bool last = (t == nt - 2);
            const char* a1 = cA + (unsigned)(t + 1) * kstep;
            const char* a2 = last ? nA : cA + (unsigned)(t + 2) * kstep; const char* b2 = last ? nB : cB + (unsigned)(t + 2) * kstep;
            const char* a3 = a2 + kstep; const char* b3 = b2 + kstep;
            PG8_LDB(B0, 0, 0); PG8_LDB(B1, 0, 1); PG8_SCHED; PG8_LDA(At, 0, 0); PG8_STAGE(PG8_SA(1, 1), a1 + hA, voffA);
            PG8_WAIT_V(8); PG8_WAIT_L(0); PG8_BAR; PG8_MMA(0, 0, At, B0); PG8_MMA(0, 1, At, B1); PG8_BAR; PG8_SCHED;
            PG8_LDA(At, 0, 1); PG8_STAGE(PG8_SB(0, 0), b2, voffB); PG8_STAGE(PG8_SB(0, 1), b2 + hB, voffB); PG8_STAGE(PG8_SA(0, 0), a2, voffA);
            PG8_WAIT_V(8); PG8_WAIT_L(0); PG8_BAR; PG8_MMA(1, 0, At, B0); PG8_MMA(1, 1, At, B1); PG8_BAR; PG8_SCHED;
            PG8_LDB(B0, 1, 0); PG8_LDB(B1, 1, 1); PG8_SCHED; PG8_LDA(At, 1, 0); PG8_STAGE(PG8_SA(0, 1), a2 + hA, voffA);
            PG8_WAIT_V(8); PG8_WAIT_L(0); PG8_BAR; PG8_MMA(0, 0, At, B0); PG8_MMA(0, 1, At, B1); PG8_BAR; PG8_SCHED;
            PG8_LDA(At, 1, 1); PG8_STAGE(PG8_SB(1, 0), b3, voffB); PG8_STAGE(PG8_SB(1, 1), b3 + hB, voffB); PG8_STAGE(PG8_SA(1, 0), a3, voffA);
            PG8_WAIT_V(8); PG8_WAIT_L(0); PG8_BAR; PG8_MMA(1, 0, At, B0); PG8_MMA(1, 1, At, B1); PG8_BAR; PG8_SCHED;
        }
        constexpr bool AD = epi_after_drain<Epi>::value;
        if constexpr (!AD) { if (wr == 0) PG8_BAR;
            E(acc, cur, wr, wc, fr, fq); }
        if (!has_next) break;
#pragma unroll
        for (int a = 0; a < 2; ++a)
#pragma unroll
            for (int b = 0; b < 2; ++b)
#pragma unroll
                for (int m = 0; m < 4; ++m)
#pragma unroll
                    for (int n = 0; n < 2; ++n) acc[a][b][m][n] = (f32x4){0.f, 0.f, 0.f, 0.f};
        cur = nxt; cA = nA; cB = nB; ++ui;
        if constexpr (!epi_after_drain<Epi>::value) { if (wr == 1) PG8_BAR; }
    }
    PG8_WAIT_V(0);
    if constexpr (epi_after_drain<Epi>::value) { if (wr == 0) PG8_BAR; }
    PG8_BAR;
    if constexpr (epi_after_drain<Epi>::value) E.fused(acc, cur, wr, wc, fr, fq, lds, wid, lane);
#undef PG8_SA
#undef PG8_SB
#undef PG8_STAGE
#undef PG8_LDA
#undef PG8_LDB
#undef PG8_MMA
#undef PG8_WAIT_V
#undef PG8_WAIT_L
#undef PG8_BAR
#undef PG8_SCHED
}
}

__device__ __forceinline__ void transpose_item(const float* W, int K, int N, bf16_t* WT, int halfN, LAS unsigned short* scr, int item, int lane) {
    const int nblk = N / 64, kb = item / nblk, nb = item % nblk, k0 = 64 * kb, n0 = 64 * nb;
    int r0 = n0; if (halfN) r0 = n0 < halfN ? (n0 / 128) * 256 + (n0 % 128) : ((n0 - halfN) / 128) * 256 + 128 + ((n0 - halfN) % 128);
    const int lk = lane >> 4, ln = (lane & 15) * 4;
    f32x4 t[16];
#pragma unroll
    for (int i = 0; i < 16; ++i) t[i] = *(const f32x4*)(W + (size_t)(k0 + 4 * i + lk) * N + n0 + ln);
#pragma unroll
    for (int i = 0; i < 16; ++i) { u32x2 w; w.x = cvt_pk_bf16(t[i][0], t[i][1]); w.y = cvt_pk_bf16(t[i][2], t[i][3]);
        LAS unsigned* p = (LAS unsigned*)(scr + (4 * i + lk) * 66 + ln); p[0] = w.x; p[1] = w.y; }
    LDS_WAIT();
    const int c = lane & 7;
#pragma unroll
    for (int j = 0; j < 8; ++j) { const int n = (lane >> 3) + 8 * j; const LAS unsigned short* sp = scr + (8 * c) * 66 + n;
        u32x4 o; o.x = (unsigned)sp[0] | ((unsigned)sp[66] << 16); o.y = (unsigned)sp[2 * 66] | ((unsigned)sp[3 * 66] << 16); o.z = (unsigned)sp[4 * 66] | ((unsigned)sp[5 * 66] << 16); o.w = (unsigned)sp[6 * 66] | ((unsigned)sp[7 * 66] << 16);
        *(u32x4*)(WT + (size_t)(r0 + n) * K + k0 + 8 * c) = o; }
    LDS_WAIT();
}

constexpr int NR = 4;
__device__ __forceinline__ void rowpass(int gw, int NGW, int lane, const float* h_f32, float* hbuf, int hin_mode, int hout_mode, const bf16_t* add, const float* g_add,
                                        bf16_t* out1, const float* g1, int mode1, bf16_t* out2, const float* g2) {
    for (int row0 = gw * NR; row0 < L; row0 += NGW * NR) {
        f32x4 v[NR][4]; u32x2 av[NR][4];
        if (hin_mode == 0) {
#pragma unroll
            for (int r = 0; r < NR; ++r)
#pragma unroll
                for (int j = 0; j < 4; ++j) v[r][j] = ((const f32x4*)(h_f32 + (size_t)(row0 + r) * D))[64 * j + lane];
        } else {
#pragma unroll
            for (int r = 0; r < NR; ++r)
#pragma unroll
                for (int j = 0; j < 4; ++j) { const u32x2 t = ((const u32x2*)((const bf16_t*)hbuf + (size_t)(row0 + r) * 2 * D + D))[64 * j + lane]; v[r][j] = (f32x4){bf_lo(t.x), bf_hi(t.x), bf_lo(t.y), bf_hi(t.y)}; }
        }
        if (add) {
#pragma unroll
            for (int r = 0; r < NR; ++r)
#pragma unroll
                for (int j = 0; j < 4; ++j) av[r][j] = ((const u32x2*)(add + (size_t)(row0 + r) * D))[64 * j + lane];
            float ss[NR];
#pragma unroll
            for (int r = 0; r < NR; ++r) { float s_ = 0.f;
#pragma unroll
                for (int j = 0; j < 4; ++j) { const float a0 = bf_lo(av[r][j].x), a1 = bf_hi(av[r][j].x), a2 = bf_lo(av[r][j].y), a3 = bf_hi(av[r][j].y); s_ += (a0 * a0 + a1 * a1) + (a2 * a2 + a3 * a3); }
                ss[r] = s_; }
#pragma unroll
            for (int o = 1; o < 64; o <<= 1)
#pragma unroll
                for (int r = 0; r < NR; ++r) ss[r] += __shfl_xor(ss[r], o);
#pragma unroll
            for (int r = 0; r < NR; ++r) ss[r] = 1.0f / sqrtf(ss[r] * (1.0f / D) + EPS);
#pragma unroll
            for (int j = 0; j < 4; ++j) { const f32x4 gg = ((const f32x4*)g_add)[64 * j + lane];
#pragma unroll
                for (int r = 0; r < NR; ++r) { const f32x4 m = (f32x4){bf_lo(av[r][j].x), bf_hi(av[r][j].x), bf_lo(av[r][j].y), bf_hi(av[r][j].y)}; v[r][j] += m * ss[r] * gg; } }
        }
        if (hout_mode == 1) {
#pragma unroll
            for (int r = 0; r < NR; ++r)
#pragma unroll
                for (int j = 0; j < 4; ++j) { u32x2 w; w.x = cvt_pk_bf16(v[r][j][0], v[r][j][1]); w.y = cvt_pk_bf16(v[r][j][2], v[r][j][3]);
                    ((u32x2*)((bf16_t*)hbuf + (size_t)(row0 + r) * 2 * D + D))[64 * j + lane] = w; v[r][j] = (f32x4){bf_lo(w.x), bf_hi(w.x), bf_lo(w.y), bf_hi(w.y)}; }
        } else if (hout_mode == 2) {
#pragma unroll
            for (int r = 0; r < NR; ++r)
#pragma unroll
                for (int j = 0; j < 4; ++j) ((f32x4*)(hbuf + (size_t)(row0 + r) * D))[64 * j + lane] = v[r][j];
        }
        if (out1 || out2) {
            float ss[NR];
#pragma unroll
            for (int r = 0; r < NR; ++r) { float s_ = 0.f;
#pragma unroll
                for (int j = 0; j < 4; ++j) s_ += (v[r][j][0] * v[r][j][0] + v[r][j][1] * v[r][j][1]) + (v[r][j][2] * v[r][j][2] + v[r][j][3] * v[r][j][3]);
                ss[r] = s_; }
#pragma unroll
            for (int o = 1; o < 64; o <<= 1)
#pragma unroll
                for (int r = 0; r < NR; ++r) ss[r] += __shfl_xor(ss[r], o);
#pragma unroll
            for (int r = 0; r < NR; ++r) ss[r] = 1.0f / sqrtf(ss[r] * (1.0f / D) + EPS);
            if (out1) {
#pragma unroll
                for (int j = 0; j < 4; ++j) { const f32x4 gg = ((const f32x4*)g1)[64 * j + lane];
#pragma unroll
                    for (int r = 0; r < NR; ++r) { const f32x4 o = v[r][j] * ss[r] * gg; u32x2 w; w.x = cvt_pk_bf16(o[0], o[1]); w.y = cvt_pk_bf16(o[2], o[3]); const int row = row0 + r;
                        bf16_t* p = mode1 ? out1 + ((size_t)((16 * j + (lane >> 2)) * NCH + (row >> 4)) * AK + (row & 15) * 16 + 4 * (lane & 3)) : out1 + (size_t)row * D + 256 * j + 4 * lane;
                        *(u32x2*)p = w; } }
            }
            if (out2) {
#pragma unroll
                for (int j = 0; j < 4; ++j) { const f32x4 gg = ((const f32x4*)g2)[64 * j + lane];
#pragma unroll
                    for (int r = 0; r < NR; ++r) { const f32x4 o = v[r][j] * ss[r] * gg; u32x2 w; w.x = cvt_pk_bf16(o[0], o[1]); w.y = cvt_pk_bf16(o[2], o[3]);
                        *(u32x2*)(out2 + (size_t)(row0 + r) * D + 256 * j + 4 * lane) = w; } }
            }
        }
    }
}

__device__ __forceinline__ f32x2 cmul(f32x2 a, f32x2 b) { return (f32x2){a.x * b.x - a.y * b.y, a.x * b.y + a.y * b.x}; }
__device__ __forceinline__ void cpow_d(double are, double aim, double dt, double n, double& re, double& im) {
    const double mag = exp(are * dt * n), ang = aim * dt * n;
    const double k = rint(ang * 0.15915494309189535), r = (ang - k * 6.283185307179586) - k * 2.4492935982947064e-16, r2 = r * r;
    double s = 0.0, ts = r, cc = 0.0, tc = 1.0;
#pragma unroll
    for (int q = 0; q < 16; ++q) { s += ts; cc += tc; ts *= -r2 * (1.0 / (double)((2 * q + 2) * (2 * q + 3))); tc *= -r2 * (1.0 / (double)((2 * q + 1) * (2 * q + 2))); }
    re = mag * cc; im = mag * s;
}
struct S5In { const float *log_dt, *a_re, *a_im, *b_re, *b_im, *c_re, *c_im; };
__device__ __forceinline__ void s5_precompute(LAS unsigned char* lds, const S5In& in, int l, int g, bf16_t* BT3, bf16_t* W1T, float* SC, int tid) {
    LAS f32x2* LP = (LAS f32x2*)lds;
    LAS f32x2* BB = LP + 17 * 64;
    LAS f32x2* CC = BB + 64 * 16;
    LAS float* KT = (LAS float*)(CC + 16 * 64);
    const int lg = l * NG + g;
    LAS f32x2* LS = (LAS f32x2*)(KT + 4096);
    {
        const int p = tid & 63, dg = tid >> 6;
        const double dt = exp((double)in.log_dt[lg]), are = (double)in.a_re[lg * 64 + p], aim = (double)in.a_im[lg * 64 + p];
        for (int d = dg; d <= 16; d += 8) { double re, im; cpow_d(are, aim, dt, (double)d, re, im); LP[d * 64 + p] = (f32x2){(float)re, (float)im}; }
        if (dg == 7) { double re, im; cpow_d(are, aim, dt, 512.0, re, im); LS[p] = (f32x2){(float)re, (float)im}; }
        if (dg == 6) {
            double lr, li; cpow_d(are, aim, dt, 1.0, lr, li);
            const double nr = lr - 1.0, ni = li, den = are * are + aim * aim;
            const double fr_ = (nr * are + ni * aim) / den, fi_ = (ni * are - nr * aim) / den;
            for (int c = 0; c < 16; ++c) { const double br = (double)in.b_re[(size_t)(lg * 64 + p) * 16 + c], bi = (double)in.b_im[(size_t)(lg * 64 + p) * 16 + c];
                BB[p * 16 + c] = (f32x2){(float)(fr_ * br - fi_ * bi), (float)(fr_ * bi + fi_ * br)}; }
        }
    }
    for (int idx = tid; idx < 1024; idx += 512) { const int c = idx >> 6, p = idx & 63; CC[c * 64 + p] = (f32x2){in.c_re[(size_t)(lg * 16 + c) * 64 + p], in.c_im[(size_t)(lg * 16 + c) * 64 + p]}; }
    __syncthreads();
    if (tid < 64) { const f32x2 lt = LP[16 * 64 + tid], ls = LS[tid]; *(f32x4*)(SC + (size_t)(lg * 64 + tid) * 4) = (f32x4){lt.x, lt.y, ls.x, ls.y}; }
    for (int idx = tid; idx < 4096; idx += 512) { const int d = idx >> 8, c = (idx >> 4) & 15, c2 = idx & 15; float s = 0.f;
        for (int p = 0; p < 64; ++p) { const f32x2 t = cmul(CC[c * 64 + p], LP[d * 64 + p]); const f32x2 b = BB[p * 16 + c2]; s += t.x * b.x - t.y * b.y; }
        KT[idx] = s; }
    __syncthreads();
    bf16_t* bt3 = BT3 + (size_t)lg * 256 * AK;
    for (int ch = tid; ch < 256 * 48; ch += 512) { const int n = ch / 48, kc = ch % 48, k0 = kc * 8, i = n >> 4, c = n & 15; float v[8];
        if (k0 < 256) { const int j = k0 >> 4, c0 = k0 & 15;
#pragma unroll
            for (int e = 0; e < 8; ++e) v[e] = (i >= j) ? KT[((i - j) * 16 + c) * 16 + c0 + e] : 0.f;
        } else { const int p0 = (k0 - 256) >> 1;
#pragma unroll
            for (int e = 0; e < 4; ++e) { const f32x2 t = cmul(CC[c * 64 + p0 + e], LP[(i + 1) * 64 + p0 + e]); v[2 * e] = t.x; v[2 * e + 1] = -t.y; } }
        *(u32x4*)(bt3 + (size_t)n * AK + k0) = (u32x4){cvt_pk_bf16(v[0], v[1]), cvt_pk_bf16(v[2], v[3]), cvt_pk_bf16(v[4], v[5]), cvt_pk_bf16(v[6], v[7])}; }
    bf16_t* w1t = W1T + (size_t)lg * 128 * 256;
    for (int ch = tid; ch < 128 * 32; ch += 512) { const int n = ch >> 5, kc = ch & 31, k0 = kc * 8, p = n >> 1, ri = n & 1, j = k0 >> 4, c0 = k0 & 15; float v[8];
#pragma unroll
        for (int e = 0; e < 8; ++e) { const f32x2 t = cmul(LP[(15 - j) * 64 + p], BB[p * 16 + c0 + e]); v[e] = ri ? t.y : t.x; }
        *(u32x4*)(w1t + (size_t)n * 256 + k0) = (u32x4){cvt_pk_bf16(v[0], v[1]), cvt_pk_bf16(v[2], v[3]), cvt_pk_bf16(v[4], v[5]), cvt_pk_bf16(v[6], v[7])}; }
    __syncthreads();
}

__device__ __forceinline__ void s5_scan(LAS unsigned char* lds, const float* S, const float* SC, bf16_t* Aext, float* xq, unsigned* cq, int l, int G, int c, int tid) {
    const int p = tid & 63, seg = tid >> 6, lane = tid & 63;
    LAS f32x2* E = (LAS f32x2*)(lds + 131072 + 512);
    for (int u = c; u < 256; u += G) {
        const int g = (G == 256) ? (u & 7) * 8 + (u >> 5) : (u >> 2), q = (G == 256) ? (u >> 3) & 3 : (u & 3);
        const f32x4 k4 = *(const f32x4*)(SC + (size_t)((l * NG + g) * 64 + p) * 4);
        const f32x2 lamT = (f32x2){k4[0], k4[1]}, lamS = (f32x2){k4[2], k4[3]};
        f32x2 lamQ = lamS;
#pragma unroll
        for (int i = 0; i < 3; ++i) lamQ = cmul(lamQ, lamQ);
        const LAS float* sp = (const LAS float*)lds + (seg * 32) * 128 + 2 * p;
        f32x2 sv[32];
#pragma unroll
        for (int kk = 0; kk < 32; ++kk) sv[kk] = *(const LAS f32x2*)(sp + kk * 128);
        f32x2 e = (f32x2){0.f, 0.f};
#pragma unroll
        for (int kk = 0; kk < 32; ++kk) e = cmul(lamT, e) + sv[kk];
        E[seg * 64 + p] = e;
        __syncthreads();
        float* slots = xq + (size_t)((l * NG + g) * 4) * 128; unsigned* cw = cq + (l * NG + g) * 64;
        if (seg == 0) {
            f32x2 t = (f32x2){0.f, 0.f};
#pragma unroll
            for (int s2 = 0; s2 < 8; ++s2) t = cmul(lamS, t) + E[s2 * 64 + p];
            __hip_atomic_store(slots + q * 128 + 2 * p, t.x, __ATOMIC_RELAXED, __HIP_MEMORY_SCOPE_AGENT);
            __hip_atomic_store(slots + q * 128 + 2 * p + 1, t.y, __ATOMIC_RELAXED, __HIP_MEMORY_SCOPE_AGENT);
            asm volatile("s_waitcnt vmcnt(0)" ::: "memory");
            if (lane == 0) __hip_atomic_fetch_add(cw, 1u, __ATOMIC_RELAXED, __HIP_MEMORY_SCOPE_AGENT);
            unsigned spn = 0;
            while ((unsigned)__builtin_amdgcn_readfirstlane(__hip_atomic_load(cw, __ATOMIC_RELAXED, __HIP_MEMORY_SCOPE_AGENT)) < 4u) { __builtin_amdgcn_s_sleep(1); if (++spn > (1u << 22)) break; }
            __builtin_amdgcn_fence(__ATOMIC_ACQUIRE, "agent");
            f32x2 cin = (f32x2){0.f, 0.f};
            for (int q2 = 0; q2 < q; ++q2) { const f32x2 tq = (f32x2){__hip_atomic_load(slots + q2 * 128 + 2 * p, __ATOMIC_RELAXED, __HIP_MEMORY_SCOPE_AGENT), __hip_atomic_load(slots + q2 * 128 + 2 * p + 1, __ATOMIC_RELAXED, __HIP_MEMORY_SCOPE_AGENT)};
                cin = cmul(lamQ, cin) + tq; }
            E[8 * 64 + p] = cin;
        }
        __syncthreads();
        f32x2 x = E[8 * 64 + p];
        for (int s2 = 0; s2 < seg; ++s2) x = cmul(lamS, x) + E[s2 * 64 + p];
        bf16_t* xp = Aext + ((size_t)g * NCH + q * 256 + seg * 32) * AK + 256 + 2 * p;
#pragma unroll
        for (int kk = 0; kk < 32; ++kk) { *(unsigned*)(xp + (size_t)kk * AK) = cvt_pk_bf16(x.x, x.y); x = cmul(lamT, x) + sv[kk]; }
        asm volatile("s_waitcnt vmcnt(0)" ::: "memory");
        __syncthreads();
    }
}

template <bool DIAGB>
__device__ __forceinline__ bool attn_block(LAS unsigned char* ldsK, LAS unsigned char* ldsV, const bf16x8 (&qf)[2], f32x4 (&oacc)[4], float& log_rest, int w, int fr, int fq, int ql, int bp16, int bp32) {
    int lim = ql; asm volatile("" : "+v"(lim));
    float base = log_rest;
    bool done = false;
#pragma unroll
    for (int ks = 3; ks >= 0; --ks) {
        if ((!DIAGB || 2 * ks <= w) && !done) {
            f32x4 z[2], l1[2]; float Gs[2];
#pragma unroll
            for (int t = 0; t < 2; ++t) { const int n = 2 * ks + t;
                z[t] = (f32x4){0.f, 0.f, 0.f, 0.f};
#pragma unroll
                for (int kk = 0; kk < 2; ++kk) { const bf16x8 a = *(const LAS bf16x8*)(ldsK + (16 * n + fr) * 144 + (32 * kk + 8 * fq) * 2); z[t] = __builtin_amdgcn_mfma_f32_16x16x32_bf16(a, qf[kk], z[t], 0, 0, 0); }
#pragma unroll
                for (int r = 0; r < 4; ++r) { const float zz = z[t][r], sp = __builtin_amdgcn_logf(1.0f + __builtin_amdgcn_exp2f(-fabsf(zz))); const float mn = __builtin_amdgcn_fmed3f(zz, 0.f, -3.0e38f); const float lb = mn - sp; float lm = lb - zz;
                    if (DIAGB) { const bool valid = (16 * n + 4 * fq + r) < lim; lm = valid ? lm : 0.f; }
                    z[t][r] = lb; l1[t][r] = lm; }
                Gs[t] = (l1[t][0] + l1[t][1]) + (l1[t][2] + l1[t][3]); }
            unsigned pk[2][2];
#pragma unroll
            for (int t = 1; t >= 0; --t) { const int n = 2 * ks + t;
                const float g0 = Gs[t], p = __builtin_bit_cast(float, __builtin_amdgcn_ds_bpermute(bp16, __builtin_bit_cast(int, g0))), tt = g0 + p;
                const float q = __builtin_bit_cast(float, __builtin_amdgcn_ds_bpermute(bp32, __builtin_bit_cast(int, tt)));
                const float Tn = tt + q, sfx = ((fq & 1) ? 0.f : p) + ((fq < 2) ? q : 0.f);
                const float b0 = base + sfx;
                const float lt3 = b0, lt2 = b0 + l1[t][3], lt1 = lt2 + l1[t][2], lt0 = lt1 + l1[t][1];
                float w0 = __builtin_amdgcn_exp2f(z[t][0] + lt0), w1 = __builtin_amdgcn_exp2f(z[t][1] + lt1), w2 = __builtin_amdgcn_exp2f(z[t][2] + lt2), w3 = __builtin_amdgcn_exp2f(z[t][3] + lt3);
                if (DIAGB) { const int kb = 16 * n + 4 * fq; w0 = (kb + 0 < lim) ? w0 : 0.f; w1 = (kb + 1 < lim) ? w1 : 0.f; w2 = (kb + 2 < lim) ? w2 : 0.f; w3 = (kb + 3 < lim) ? w3 : 0.f; }
                pk[t][0] = cvt_pk_bf16(w0, w1); pk[t][1] = cvt_pk_bf16(w2, w3);
                base += Tn; }
            const u32x4 bwv = (u32x4){pk[0][0], pk[0][1], pk[1][0], pk[1][1]};
            const bf16x8 bw = __builtin_bit_cast(bf16x8, bwv);
#pragma unroll
            for (int nt = 0; nt < 4; ++nt) { const LAS unsigned char* vp = ldsV + (16 * nt + fr) * 272 + (32 * ks + 4 * fq) * 2;
                const s16x4 lo = *(const LAS s16x4*)vp, hi = *(const LAS s16x4*)(vp + 32);
                const bf16x8 a = __builtin_shufflevector(lo, hi, 0, 1, 2, 3, 4, 5, 6, 7);
                oacc[nt] = __builtin_amdgcn_mfma_f32_16x16x32_bf16(a, bw, oacc[nt], 0, 0, 0); }
            if ((ks & 1) == 0) done = __all(base <= -150.1f) != 0;
        }
    }
    log_rest = base;
    return done;
}

__device__ __forceinline__ void attn_phase(LAS unsigned char* lds, const bf16_t* Q, const bf16_t* Kb, const bf16_t* Vt, bf16_t* O, int G, int c, int tid) {
    const int w = __builtin_amdgcn_readfirstlane(tid >> 6), lane = tid & 63, fr = lane & 15, fq = lane >> 4;
    const int bp16 = (lane ^ 16) << 2, bp32 = (lane ^ 32) << 2;
    LAS unsigned char* ldsK = lds; LAS unsigned char* ldsV = lds + 18432; volatile LAS int* flags = (volatile LAS int*)(lds + 35840);
    for (int u = c; u < 2048; u += G) {
        const int h = u & 15, qb = u >> 4, ql = 16 * w + fr;
        const size_t qrow = (size_t)qb * 128 + ql;
        bf16x8 qf[2];
#pragma unroll
        for (int ks = 0; ks < 2; ++ks) qf[ks] = *(const bf16x8*)(Q + qrow * D + h * 64 + 32 * ks + 8 * fq);
        f32x4 oacc[4];
#pragma unroll
        for (int i = 0; i < 4; ++i) oacc[i] = (f32x4){0.f, 0.f, 0.f, 0.f};
        float log_rest = 0.f; int mydone = 0;
        const int skey0 = tid >> 3, sch0 = tid & 7, sd0 = tid >> 4, sch1 = tid & 15;
        const bf16_t* kp = Kb + (size_t)skey0 * D + h * 64 + sch0 * 8;
        const bf16_t* vp0 = Vt + (size_t)(h * 64 + sd0) * L + sch1 * 8;
        u32x4 pk0 = *(const u32x4*)(kp + (size_t)128 * qb * D), pk1 = *(const u32x4*)(kp + (size_t)(128 * qb + 64) * D);
        u32x4 pv0 = *(const u32x4*)(vp0 + 128 * qb), pv1 = *(const u32x4*)(vp0 + (size_t)32 * L + 128 * qb);
        for (int j = qb; j >= 0; --j) {
            __syncthreads();
            if (j < qb) { int all = 1;
#pragma unroll
                for (int i = 0; i < 8; ++i) all &= flags[i];
                if (all && !DIAG_NOEXIT) break; }
            *(LAS u32x4*)(ldsK + skey0 * 144 + sch0 * 16) = pk0; *(LAS u32x4*)(ldsK + (skey0 + 64) * 144 + sch0 * 16) = pk1;
            *(LAS u32x4*)(ldsV + sd0 * 272 + sch1 * 16) = pv0;   *(LAS u32x4*)(ldsV + (sd0 + 32) * 272 + sch1 * 16) = pv1;
            __syncthreads();
            if (j > 0) { const int jn = j - 1;
                pk0 = *(const u32x4*)(kp + (size_t)128 * jn * D); pk1 = *(const u32x4*)(kp + (size_t)(128 * jn + 64) * D);
                pv0 = *(const u32x4*)(vp0 + 128 * jn); pv1 = *(const u32x4*)(vp0 + (size_t)32 * L + 128 * jn); }
            if (!mydone) {
            bool dn;
            if (j == qb) dn = attn_block<true>(ldsK, ldsV, qf, oacc, log_rest, w, fr, fq, ql, bp16, bp32); else dn = attn_block<false>(ldsK, ldsV, qf, oacc, log_rest, w, fr, fq, ql, bp16, bp32);
            mydone = dn ? 1 : 0;
            if (lane == 0) flags[w] = mydone;
            }
        }
#pragma unroll
        for (int nt = 0; nt < 4; ++nt) { u32x2 o; o.x = cvt_pk_bf16(oacc[nt][0], oacc[nt][1]); o.y = cvt_pk_bf16(oacc[nt][2], oacc[nt][3]);
            *(u32x2*)(O + qrow * D + h * 64 + 16 * nt + 4 * fq) = o; }
    }
}


#define XB_TMO      128
#define XB_XCNT(j)  (256  + 64 * (j))
#define XB_XSUB(j)  (1280 + 64 * (j))
#define XB_XGEN(j)  (2304 + 64 * (j))
#define XB_TOP      3328
#define XB_TOPGEN   3392
#define XCD_BAR_WORDS 3456
#define XB_SPIN_CAP (1u << 18)
__device__ __forceinline__ unsigned xb_ld(unsigned* p)              { return __hip_atomic_load(p, __ATOMIC_RELAXED, __HIP_MEMORY_SCOPE_AGENT); }
__device__ __forceinline__ unsigned xb_add(unsigned* p, unsigned v) { return __hip_atomic_fetch_add(p, v, __ATOMIC_RELAXED, __HIP_MEMORY_SCOPE_AGENT); }
__device__ __forceinline__ unsigned xb_xcc_id() { return (unsigned)__builtin_amdgcn_s_getreg((3 << 11) | 20) & 0xFu; }
#define XB_SPIN(cond, bar) do { unsigned _sp = 0; while (cond) { __builtin_amdgcn_s_sleep(1); \
    if ((++_sp & 255u) == 0u) { if (xb_ld(&(bar)[XB_TMO])) break; if (_sp > XB_SPIN_CAP) { atomicAdd(&(bar)[XB_TMO], 1u); break; } } } } while (0)
struct XcdBarrier { unsigned* bar; unsigned x; volatile LAS unsigned* st; };
__device__ __forceinline__ XcdBarrier xcd_barrier_post(unsigned* bar, volatile LAS unsigned* st) {
    XcdBarrier b; b.bar = bar; b.x = xb_xcc_id(); b.st = st;
    if (threadIdx.x == 0) (void)xb_add(&bar[XB_XCNT(b.x)], 1u);
    return b;
}
__device__ __forceinline__ void xcd_barrier_complete(unsigned* bar, unsigned x, unsigned& nloc, unsigned& nx) {
    const unsigned G = gridDim.x * gridDim.y * gridDim.z;
    unsigned sum, cnt, mine, sp = 0u;
    for (;;) {
        sum = 0u; cnt = 0u; mine = 0u;
#pragma unroll
        for (unsigned j = 0; j < 16; ++j) { const unsigned c = xb_ld(&bar[XB_XCNT(j)]); sum += c; cnt += (c > 0u) ? 1u : 0u; mine = (j == x) ? c : mine; }
        if (sum == G) break;
        __builtin_amdgcn_s_sleep(1);
        if ((++sp & 255u) == 0u) { if (xb_ld(&bar[XB_TMO])) break; if (sp > XB_SPIN_CAP) { atomicAdd(&bar[XB_TMO], 1u); break; } }
    }
    nloc = mine > 0u ? mine : 1u; nx = cnt > 0u ? cnt : 1u;
}
__device__ __forceinline__ void xcd_barrier(const XcdBarrier& b) {
    asm volatile("s_waitcnt vmcnt(0)" ::: "memory");
    __syncthreads();
    if (threadIdx.x == 0) {
        unsigned* bar = b.bar;
        __builtin_amdgcn_s_waitcnt(0);
        unsigned nloc = b.st[0], nx = b.st[1];
        if (nloc == 0u) { xcd_barrier_complete(bar, b.x, nloc, nx); b.st[0] = nloc; b.st[1] = nx; }
        const unsigned old = xb_add(&bar[XB_XSUB(b.x)], 1u);
        const unsigned gen = old / nloc;
        if (old + 1u == (gen + 1u) * nloc) {
            __builtin_amdgcn_fence(__ATOMIC_RELEASE, "agent");
            asm volatile("s_waitcnt vmcnt(0)" ::: "memory");
            const unsigned og = xb_add(&bar[XB_TOP], 1u);
            const unsigned tg = og / nx;
            if (og + 1u == (tg + 1u) * nx) xb_add(&bar[XB_TOPGEN], 1u);
            else XB_SPIN(xb_ld(&bar[XB_TOPGEN]) == tg, bar);
            __builtin_amdgcn_fence(__ATOMIC_ACQUIRE, "agent");
            xb_add(&bar[XB_XGEN(b.x)], 1u);
            asm volatile("s_waitcnt vmcnt(0)" ::: "memory");
        } else {
            XB_SPIN(xb_ld(&bar[XB_XGEN(b.x)]) == gen, bar);
            __builtin_amdgcn_fence(__ATOMIC_ACQUIRE, "agent");
            asm volatile("s_waitcnt vmcnt(0)" ::: "memory");
        }
    }
    __syncthreads();
}

__device__ __forceinline__ float bf1(const bf16_t* p) { return __uint_as_float(((unsigned)*p) << 16); }
__device__ __forceinline__ float wave_max(float v) {
#pragma unroll
    for (int o = 1; o < 64; o <<= 1) v = fmaxf(v, __shfl_xor(v, o));
    return v;
}
__device__ __forceinline__ void diag_s5(const S5In& in, const float* dskip, const bf16_t* Aext, const bf16_t* Y, float* res, int tid) {
    if (tid < 64) {
        const int p = tid, g = 5, lg = g;
        const double dtd = exp((double)in.log_dt[lg]), are = (double)in.a_re[lg * 64 + p], aim = (double)in.a_im[lg * 64 + p];
        double lr, li; cpow_d(are, aim, dtd, 1.0, lr, li);
        const double nr = lr - 1.0, ni = li, den = are * are + aim * aim;
        const double fr_ = (nr * are + ni * aim) / den, fi_ = (ni * are - nr * aim) / den;
        const f32x2 lam = (f32x2){(float)lr, (float)li};
        f32x2 bb[16], cc[16]; float dd[16];
#pragma unroll
        for (int c = 0; c < 16; ++c) { const double br = (double)in.b_re[(size_t)(lg * 64 + p) * 16 + c], bi = (double)in.b_im[(size_t)(lg * 64 + p) * 16 + c];
            bb[c] = (f32x2){(float)(fr_ * br - fi_ * bi), (float)(fr_ * bi + fi_ * br)};
            cc[c] = (f32x2){in.c_re[(size_t)(lg * 16 + c) * 64 + p], in.c_im[(size_t)(lg * 16 + c) * 64 + p]}; dd[c] = dskip[g * 16 + c]; }
        f32x2 x = (f32x2){0.f, 0.f}; float maxd = 0.f, maxa = 0.f;
        for (int t = 0; t < 2048; ++t) {
            const bf16_t* up = Aext + ((size_t)(g * NCH + (t >> 4)) * AK + (t & 15) * 16);
            const u32x4 u0 = *(const u32x4*)up, u1 = *((const u32x4*)up + 1);
            float uu[16] = {bf_lo(u0.x), bf_hi(u0.x), bf_lo(u0.y), bf_hi(u0.y), bf_lo(u0.z), bf_hi(u0.z), bf_lo(u0.w), bf_hi(u0.w), bf_lo(u1.x), bf_hi(u1.x), bf_lo(u1.y), bf_hi(u1.y), bf_lo(u1.z), bf_hi(u1.z), bf_lo(u1.w), bf_hi(u1.w)};
            f32x2 bu = (f32x2){0.f, 0.f};
#pragma unroll
            for (int c = 0; c < 16; ++c) bu += bb[c] * uu[c];
            x = cmul(lam, x) + bu;
#pragma unroll
            for (int c = 0; c < 16; ++c) { float yc = cc[c].x * x.x - cc[c].y * x.y; yc = wave_sum(yc); yc += dd[c] * uu[c];
                const float tt = 1.5957691216057308f * (yc + 0.044715f * yc * yc * yc); yc = yc / (1.0f + expf(-tt));
                const float got = bf1(Y + (size_t)t * D + g * 16 + c); maxd = fmaxf(maxd, fabsf(yc - got)); maxa = fmaxf(maxa, fabsf(yc)); }
        }
        if (p == 0) res[0] = maxd / maxa;
    }
}
__device__ __forceinline__ void diag_attn(const bf16_t* Q, const bf16_t* Kb, const bf16_t* Vt, const bf16_t* O, float* res, int tid) {
    const int w = tid >> 6, d = tid & 63;
    const int t = 40 * 128 + (w == 0 ? 0 : w == 1 ? 15 : w == 2 ? 16 : w == 3 ? 64 : w == 4 ? 100 : w == 5 ? 120 : w == 6 ? 125 : 127), h = 3;
    const float q = bf1(Q + (size_t)t * D + h * 64 + d);
    float acc = 0.f, o = 0.f; const int s_lo = t - 600 > 0 ? t - 600 : 0;
    for (int s = t - 1; s >= s_lo; --s) { const float z = wave_sum(q * bf1(Kb + (size_t)s * D + h * 64 + d)); const float sp = logf(1.0f + expf(-fabsf(z))), lb = fminf(z, 0.f) - sp;
        const float wgt = expf(lb + acc); acc += lb - z; o += wgt * bf1(Vt + (size_t)(h * 64 + d) * L + s); }
    const float got = bf1(O + (size_t)t * D + h * 64 + d);
    const float dd = wave_max(fabsf(o - got)), aa = wave_max(fabsf(o));
    if (d == 0) res[1 + w] = dd / aa;
}
__device__ __forceinline__ float digit_of(float err) { float dgt = -2.0f * log10f(fmaxf(err, 1e-6f)); return fminf(fmaxf(rintf(dgt), 0.f), 9.f); }

struct Args { const float* in[22]; float* out; unsigned char* ws; int ph_lo, ph_hi; };

__global__ void __launch_bounds__(512, 2) mk_fwd(Args a) {
    extern __shared__ __attribute__((aligned(16))) unsigned char lds_raw[];
    LAS unsigned char* lds = (LAS unsigned char*)lds_raw;
    cg::grid_group grid = cg::this_grid();
    volatile LAS unsigned* xst = (volatile LAS unsigned*)(lds + 131072 + 64);
    if (threadIdx.x < 2) xst[threadIdx.x] = 0u;
    __syncthreads();
    const XcdBarrier xbar = xcd_barrier_post((unsigned*)a.ws, xst);
    const int G0 = gridDim.x, c0 = blockIdx.x;
    typedef const __attribute__((address_space(4))) Args* KArgs;
    const int lo = a.ph_lo, hi = a.ph_hi; (void)lo; (void)hi;
    int ph = 0; (void)ph;
#if DIAG == 3
    unsigned long long t0_ = __builtin_amdgcn_s_memrealtime(), tacc = 0; int cur_group = 0;
#define GRP(g) cur_group = (g);
#else
#define GRP(g)
#endif
#if MK_ONE_LAUNCH
#define PH_COND true
#define PH_SYNC(last) if (!(last)) { if (USE_CG_SYNC) grid.sync(); else xcd_barrier(xbar); }
#else
#define PH_COND (ph >= lo && ph < hi)
#define PH_SYNC(last)
#endif
#define PH_BEGIN if (PH_COND) { int tid = threadIdx.x; asm volatile("" : "+v"(tid)); int c = c0, G = G0; asm volatile("" : "+s"(c), "+s"(G)); const int NGW = G * 8; (void)NGW; const int lane = tid & 63, wave = __builtin_amdgcn_readfirstlane(tid >> 6), gw = c * 8 + wave; (void)lane; (void)gw; \
    KArgs ap = (KArgs)__builtin_amdgcn_kernarg_segment_ptr(); asm volatile("" : "+s"(ap)); unsigned char* ws = ap->ws; float* out = ap->out; const float* x = ap->in[0]; (void)out; (void)x; \
    bf16_t* WIN = (bf16_t*)(ws + WS_WIN); bf16_t* WOUT = (bf16_t*)(ws + WS_WOUT); bf16_t* WGLU = (bf16_t*)(ws + WS_WGLU); \
    bf16_t* WK = (bf16_t*)(ws + WS_WK); bf16_t* WV = (bf16_t*)(ws + WS_WV); bf16_t* WQ = (bf16_t*)(ws + WS_WQ); bf16_t* WO = (bf16_t*)(ws + WS_WO); \
    bf16_t* BT3 = (bf16_t*)(ws + WS_BT3); bf16_t* W1T = (bf16_t*)(ws + WS_W1T); float* SC = (float*)(ws + WS_SC); \
    bf16_t* AEXT = (bf16_t*)(ws + WS_AEXT); float* Sb = (float*)(ws + WS_S); bf16_t* ACT = (bf16_t*)(ws + WS_ACT); bf16_t* MIX = (bf16_t*)(ws + WS_MIX); \
    bf16_t* VT = (bf16_t*)(ws + WS_VT); bf16_t* KB = (bf16_t*)(ws + WS_KB); bf16_t* Yb = (bf16_t*)(ws + WS_Y); bf16_t* Qb = (bf16_t*)(ws + WS_Q); bf16_t* Ob = (bf16_t*)(ws + WS_O); bf16_t* HK = (bf16_t*)(ws + WS_HK); \
    (void)WIN; (void)WOUT; (void)WGLU; (void)WK; (void)WV; (void)WQ; (void)WO; (void)BT3; (void)W1T; (void)SC; (void)AEXT; (void)Sb; (void)ACT; (void)MIX; (void)VT; (void)KB; (void)Yb; (void)Qb; (void)Ob; (void)HK;
#if DIAG == 3
#define PH_STAMP { const unsigned long long t1_ = __builtin_amdgcn_s_memrealtime(); if (cur_group == DIAG_GROUP) tacc += t1_ - t0_; t0_ = t1_; }
#else
#define PH_STAMP
#endif
#define PH_END   PH_SYNC(false) PH_STAMP } ++ph;
#define PH_END_CG   if (lo == 0x7fffffff) grid.sync();   xcd_barrier(xbar); } ++ph;
#define PH_END_LAST(last)   PH_SYNC(last) PH_STAMP } ++ph;

    DUPFOR(0) PH_BEGIN
        if (c < 128) { S5In in{ap->in[7], ap->in[8], ap->in[9], ap->in[10], ap->in[11], ap->in[12], ap->in[13]}; s5_precompute(lds, in, c >> 6, c & 63, BT3, W1T, SC, tid); }
        LAS unsigned short* scr = (LAS unsigned short*)(lds + wave * 16384);
        constexpr int I_IN = 16 * 88, I_OUT = 44 * 16, I_GLU = 16 * 32, I_SQ = 16 * 16;
        constexpr int NITEMS = 4 * I_IN + I_OUT + 2 * I_GLU + 6 * I_SQ;
        for (int it = gw; it < NITEMS; it += NGW) {
            int r = it;
            if (r < 4 * I_IN) { const int l = r / I_IN; transpose_item(ap->in[5] + (size_t)l * D * 2 * DFF, D, 2 * DFF, WIN + (size_t)l * 2 * DFF * D, DFF, scr, r % I_IN, lane); continue; } r -= 4 * I_IN;
            if (r < I_OUT) { transpose_item(ap->in[6], DFF, D, WOUT, 0, scr, r, lane); continue; } r -= I_OUT;
            if (r < 2 * I_GLU) { const int l = r / I_GLU; transpose_item(ap->in[15] + (size_t)l * D * 2 * D, D, 2 * D, WGLU + (size_t)l * 2 * D * D, D, scr, r % I_GLU, lane); continue; } r -= 2 * I_GLU;
            const int wsel = r / I_SQ; r %= I_SQ;
            const float* src = wsel == 0 ? ap->in[18] : wsel == 1 ? ap->in[19] : wsel < 4 ? ap->in[20] + (size_t)(wsel - 2) * D * D : ap->in[21] + (size_t)(wsel - 4) * D * D;
            bf16_t* dst = wsel == 0 ? WK : wsel == 1 ? WV : wsel < 4 ? WQ + (size_t)(wsel - 2) * D * D : WO + (size_t)(wsel - 4) * D * D;
            transpose_item(src, D, D, dst, 0, scr, r, lane);
        }
        rowpass(gw, NGW, lane, x, nullptr, 0, 0, nullptr, nullptr, AEXT, ap->in[1], 1, nullptr, nullptr);
    PH_END_CG

#if EXTRA_SYNCS
    for (int i_ = 0; i_ < EXTRA_SYNCS; ++i_) xcd_barrier(xbar);
#endif
    for (int l = 0; l < 4; ++l) {
        if (l < 2) {
            PH_BEGIN
                { pg8::Gemm g{AEXT, W1T + (size_t)l * NG * 128 * 256, NCH, 256, 256, AK, 256, NG, (unsigned)NCH * AK, 128u * 256u};
                  pg8::EpiS5State E{}; pg8::gemm_phase(lds, g, E, G, c, tid); }
                __syncthreads();
                s5_scan(lds, Sb, SC, AEXT, (float*)(ws + WS_XCH + 3 * MiB), (unsigned*)(ws + WS_CNT2), l, G, c, tid);
                { pg8::Gemm g{AEXT, BT3 + (size_t)l * NG * 256 * AK, NCH, 256, AK, AK, AK, NG, (unsigned)NCH * AK, 256u * AK};
                  pg8::EpiS5Out E{AEXT, ap->in[14] + (size_t)l * NG * 16, Yb}; pg8::gemm_phase(lds, g, E, G, c, tid); }
            PH_END
            DUPFOR(2) PH_BEGIN
#if DIAG == 1
                if (l == 0) { if (c == 0) { S5In in{ap->in[7], ap->in[8], ap->in[9], ap->in[10], ap->in[11], ap->in[12], ap->in[13]}; diag_s5(in, ap->in[14], AEXT, Yb, (float*)ws, tid); if (tid == 0) out[0] = (digit_of(((float*)ws)[0]) + 1.f) * 10000.f; } return; }
#endif
                pg8::Gemm g{Yb, WGLU + (size_t)l * 2 * D * D, L, 2 * D, D, D, D, 1, 0, 0};
                pg8::EpiGLU E{MIX, D, ap->in[16] + (size_t)l * 2 * D, D}; pg8::gemm_phase(lds, g, E, G, c, tid);
            PH_END
        } else {
            const int b = l - 2;
            DUPFOR(2) PH_BEGIN
                if (l == 2) {
                    { pg8::Gemm g{HK, WK, L, D, D, D, D, 1, 0, 0}; pg8::EpiPlain E{KB, D, 1.0f}; pg8::gemm_phase(lds, g, E, G, c, tid); }
                    { pg8::Gemm g{WV, HK, D, L, D, D, D, 1, 0, 0}; pg8::EpiPlain E{VT, L, 1.0f}; pg8::gemm_phase(lds, g, E, G, c, tid); }
                }
                { pg8::Gemm g{MIX, WQ + (size_t)b * D * D, L, D, D, D, D, 1, 0, 0}; pg8::EpiPlain E{Qb, D, 0.18033688011112042f  }; pg8::gemm_phase(lds, g, E, G, c, tid); }
#if DIAG == 2
                grid.sync(); __threadfence(); grid.sync();
#endif
            PH_END
            DUPFOR(3) PH_BEGIN
                attn_phase(lds, Qb, KB, VT, Ob, G, c, tid);
            PH_END
            DUPFOR(2) PH_BEGIN
#if DIAG == 2
                if (l == 2) { if (c == 1) { diag_attn(Qb, KB, VT, Ob, (float*)ws, tid); __syncthreads(); if (tid == 0) { const float* res = (const float*)ws; int lo4 = 0, hi4 = 0; for (int i = 0; i < 4; ++i) { if (res[1 + i] > 0.1f) lo4 |= 1 << i; if (res[5 + i] > 0.1f) hi4 |= 1 << i; } float V = (10.f + (float)lo4) * 1000.f; for (int i = 0; i < hi4; ++i) V *= 10.f; out[0] = V; } } return; }
#endif
                pg8::Gemm g{Ob, WO + (size_t)b * D * D, L, D, D, D, D, 1, 0, 0};
                bf16_t* hslot = (bf16_t*)out + D;
                pg8::EpiResNorm E{hslot, 2 * D, l == 3 ? KB : hslot, l == 3 ? D : 2 * D, nullptr, ap->in[2] + l * D, MIX, ap->in[3] + l * D, 0, nullptr, nullptr, (float*)(ws + WS_XCH), (unsigned*)(ws + WS_CNT), b};
                pg8::gemm_phase(lds, g, E, G, c, tid);
            PH_END
        }
        if (l < 2) {
        DUPFOR(4) PH_BEGIN
            rowpass(gw, NGW, lane, x, out, l == 0 ? 0 : 1, 1, MIX, ap->in[2] + l * D, MIX, ap->in[3] + l * D, 0, nullptr, nullptr);
        PH_END
        }
        DUPFOR(5) PH_BEGIN
            pg8::Gemm g{MIX, WIN + (size_t)l * 2 * DFF * D, L, 2 * DFF, D, D, D, 1, 0, 0};
            pg8::EpiSwiGLU E{ACT, DFF}; pg8::gemm_phase(lds, g, E, G, c, tid);
            if (l < 3 && c >= G / 2) {
                LAS unsigned short* scr = (LAS unsigned short*)(lds + wave * 16384);
                constexpr int I_OUT = 44 * 16;
                const int hw = (c - G / 2) * 8 + wave, NHW = (G - G / 2) * 8, ln = l + 1;
                for (int it = hw; it < I_OUT; it += NHW) transpose_item(ap->in[6] + (size_t)ln * DFF * D, DFF, D, WOUT + (size_t)ln * D * DFF, 0, scr, it, lane);
            }
        PH_END
        PH_BEGIN
            pg8::Gemm g{ACT, WOUT + (size_t)l * D * DFF, L, D, DFF, DFF, DFF, 1, 0, 0};
            bf16_t* hslot = (bf16_t*)out + D;
            const bf16_t* hin = l == 3 ? KB : hslot; const int hin_pitch = l == 3 ? D : 2 * D;
            bf16_t* o1 = l == 0 ? AEXT : l == 3 ? nullptr : MIX; const float* gg1 = ap->in[1] + (l < 3 ? l + 1 : 0) * D;
            pg8::EpiResNorm E{hin, hin_pitch, hslot, 2 * D, l == 3 ? out : nullptr, ap->in[4] + l * D, o1, gg1, l == 0 ? 1 : 0, l == 1 ? HK : nullptr, ap->in[17], (float*)(ws + WS_XCH), (unsigned*)(ws + WS_CNT), 2 + l};
            pg8::gemm_phase(lds, g, E, G, c, tid);
        PH_END_LAST(DIAG != 3 && l == 3)
    }
#if DIAG == 3
    grid.sync();
    if (c0 == 0 && threadIdx.x == 0) a.out[0] = (float)tacc * 10.0f;
#endif
#undef PH_BEGIN
#undef PH_END
#undef PH_END_CG
#undef PH_END_LAST
}
constexpr int N_PHASES = 1 + 2 * 8 + 2 * 7;

extern "C" void kernel_launch(void* const* d_in, const int* in_sizes, int n_in, void* d_out, int out_size, void* d_ws, size_t ws_size, hipStream_t stream) {
    static int grid = 0;
    if (grid == 0) {
        if (n_in != 22 || in_sizes[0] != L * D || out_size != L * D || ws_size < WS_END) { fprintf(stderr, "kernel_launch: unexpected shapes (n_in %d in0 %d out %d ws %zu)\n", n_in, n_in > 0 ? in_sizes[0] : -1, out_size, ws_size); grid = -1; return; }
        int dev = 0, cus = 0, per_cu = 0;
        hipGetDevice(&dev); hipDeviceGetAttribute(&cus, hipDeviceAttributeMultiprocessorCount, dev);
        if (hipFuncSetAttribute((const void*)mk_fwd, hipFuncAttributeMaxDynamicSharedMemorySize, LDS_BYTES) != hipSuccess) { fprintf(stderr, "kernel_launch: hipFuncSetAttribute failed\n"); grid = -1; return; }
        if (hipOccupancyMaxActiveBlocksPerMultiprocessor(&per_cu, (const void*)mk_fwd, 512, LDS_BYTES) != hipSuccess || per_cu < 1) { fprintf(stderr, "kernel_launch: occupancy query says %d blocks/CU\n", per_cu); grid = -1; return; }
        if (cus != 256) { fprintf(stderr, "kernel_launch: built for a 256-CU device (one 256x256 unit per workgroup in the fused-epilogue phases); found %d CUs, nothing launched\n", cus); grid = -1; return; }
        grid = cus;
    }
    if (grid < 0) return;
    if (hipMemsetAsync(d_ws, 0, CTL_ZERO_BYTES, stream) != hipSuccess) { fprintf(stderr, "kernel_launch: memset failed\n"); return; }
    Args a{};
    for (int i = 0; i < 22; ++i) a.in[i] = (const float*)d_in[i];
    a.out = (float*)d_out; a.ws = (unsigned char*)d_ws;
#if MK_ONE_LAUNCH
    a.ph_lo = 0; a.ph_hi = N_PHASES;
    void* args[] = {&a};
    hipError_t e = hipLaunchCooperativeKernel((const void*)mk_fwd, dim3(grid), dim3(512), args, LDS_BYTES, stream);
    if (e != hipSuccess) fprintf(stderr, "cooperative launch failed: %s (grid %d)\n", hipGetErrorString(e), grid);
#else
    for (int p = 0; p < N_PHASES; ++p) { a.ph_lo = p; a.ph_hi = p + 1; hipLaunchKernelGGL(mk_fwd, dim3(grid), dim3(512), LDS_BYTES, stream, a); }
#endif
}
```

```cpp
#include <hip/hip_runtime.h>
#include <hip/hip_cooperative_groups.h>
#include <cstdio>
#include <cstdint>
namespace cg = cooperative_groups;

#ifndef DIAG
#define DIAG 0
#endif
#ifndef USE_CG_SYNC
#define USE_CG_SYNC 0
#endif
#ifndef EXTRA_SYNCS
#define EXTRA_SYNCS 0
#endif
#ifndef DUP_GROUP
#define DUP_GROUP -1
#endif
#define DUPFOR(k) for (int rep_ = 0; rep_ < ((DUP_GROUP == (k)) ? 2 : 1); ++rep_)
#ifndef DIAG_GROUP
#define DIAG_GROUP 2
#endif
#ifndef DIAG_NOEXIT
#define DIAG_NOEXIT 0
#endif
#ifndef DIAG_NIB
#define DIAG_NIB 0
#endif
#ifndef MK_ONE_LAUNCH
#define MK_ONE_LAUNCH 1
#endif

#define LAS __attribute__((address_space(3)))
typedef unsigned short bf16_t;
typedef short bf16x8 __attribute__((ext_vector_type(8)));
typedef short s16x4 __attribute__((ext_vector_type(4)));
typedef float f32x4 __attribute__((ext_vector_type(4)));
typedef float f32x2 __attribute__((ext_vector_type(2)));
typedef unsigned u32x4 __attribute__((ext_vector_type(4)));
typedef unsigned u32x2 __attribute__((ext_vector_type(2)));

constexpr int L = 16384, D = 1024, DFF = 2816, NG = 64, NCH = 1024, AK = 384;
constexpr float EPS = 1e-6f;
constexpr size_t MiB = 1u << 20;
constexpr size_t WS_WIN = 1 * MiB, WS_WOUT = 45 * MiB, WS_WGLU = 67 * MiB, WS_WK = 75 * MiB, WS_WV = 77 * MiB, WS_WQ = 79 * MiB, WS_WO = 83 * MiB;
constexpr size_t WS_BT3 = 87 * MiB, WS_W1T = 111 * MiB, WS_SC = 120 * MiB, WS_AEXT = 121 * MiB, WS_S = 169 * MiB, WS_ACT = 201 * MiB, WS_MIX = 289 * MiB, WS_XCH = 321 * MiB, WS_END = 325 * MiB;
constexpr size_t WS_VT = WS_AEXT, WS_KB = WS_S, WS_Y = WS_ACT, WS_Q = WS_ACT, WS_O = WS_ACT + 32 * MiB, WS_HK = WS_BT3;
constexpr int LDS_BYTES = 147456;
constexpr size_t WS_CNT = 65536, WS_CNT2 = 320 * 1024, CTL_ZERO_BYTES = 512 * 1024;

typedef __bf16 bf16x2_t __attribute__((ext_vector_type(2)));
__device__ __forceinline__ unsigned cvt_pk_bf16(float lo, float hi) { const f32x2 v = {lo, hi}; const bf16x2_t b = __builtin_convertvector(v, bf16x2_t); return __builtin_bit_cast(unsigned, b); }
__device__ __forceinline__ float bf_lo(unsigned w) { return __uint_as_float(w << 16); }
__device__ __forceinline__ float bf_hi(unsigned w) { return __uint_as_float(w & 0xffff0000u); }
__device__ __forceinline__ float wave_sum(float v) {
#pragma unroll
    for (int o = 1; o < 64; o <<= 1) v += __shfl_xor(v, o);
    return v;
}
#define LDS_WAIT() asm volatile("s_waitcnt lgkmcnt(0)" ::: "memory")

namespace pg8 {
constexpr int BM = 256, BK = 64, HALF = 128, HTB = HALF * BK * 2, NXCD = 8, WGM = 8;
__device__ __forceinline__ int lds_byte(int r, int c) { const int st = (r >> 4) * 2 + (c >> 5), rr = r & 15, cc = c & 31, ob = rr * 64 + cc * 2; return st * 1024 + (ob ^ (((ob >> 9) & 1) << 5)); }
__device__ __forceinline__ void stage_rc(int b, int& R, int& C) { const int st = b / 1024, sb = b % 1024, swz = sb ^ (((sb >> 9) & 1) << 5); R = (st >> 1) * 16 + swz / 64; C = (st & 1) * 32 + (swz % 64) / 2; }

__device__ __forceinline__ int perm32(int rho) { const int n = rho >> 4, i = rho & 15; return 8 * (i >> 2) + 4 * n + (i & 3); }
template <class T, class = void> struct epi_perm { static constexpr bool value = false; };
template <class T> struct epi_perm<T, decltype((void)T::PERM)> { static constexpr bool value = T::PERM; };
struct Unit { int pm, pn, b; };
struct Gemm { const bf16_t* A; const bf16_t* Bt; int M, N, K, lda, ldb, batch; unsigned bsA, bsB; };
struct Order {
    int nM, nN, per, total, G, c;
    __device__ __forceinline__ void init(int M, int N, int batch, int G_, int c_) { nM = M / BM; nN = N / BM; per = nM * nN; total = per * batch; G = G_; c = c_; }
    __device__ __forceinline__ bool next(int i, Unit& u) const {
        const int Lx = i * G + c; if (Lx >= total) return false;
        if (per == 4 && G == 256 && total == 256) { u.b = (c & 7) * 8 + (c >> 5); u.pm = (c >> 3) & 3; u.pn = 0; return true; }
        u.b = Lx / per; int wgid = Lx - u.b * per;
        { const int q = per / NXCD, r = per % NXCD, xcd = wgid % NXCD, off = wgid / NXCD; wgid = (xcd < r ? xcd * (q + 1) : r * (q + 1) + (xcd - r) * q) + off; }
        const int nig = WGM * nN, gid = wgid / nig, fm = gid * WGM, gsz = (nM - fm) < WGM ? (nM - fm) : WGM;
        u.pm = fm + ((wgid % nig) % gsz); u.pn = (wgid % nig) / gsz; return true;
    }
};

struct EpiPlain {
    static constexpr bool PERM = true;
    bf16_t* O; int ldc; float scale;
    __device__ __forceinline__ void operator()(const f32x4 (&acc)[2][2][4][2], const Unit& u, int wr, int wc, int fr, int fq) const {
        const int row0 = u.pm * BM + wr * 64 + fr, col0 = u.pn * BM + wc * 32 + 8 * fq;
#pragma unroll
        for (int ai = 0; ai < 2; ++ai)
#pragma unroll
            for (int m = 0; m < 4; ++m) { bf16_t* rowp = O + (size_t)(row0 + ai * HALF + m * 16) * ldc + col0;
#pragma unroll
                for (int bj = 0; bj < 2; ++bj) { const f32x4 v0 = acc[ai][bj][m][0] * scale, v1 = acc[ai][bj][m][1] * scale;
                    *(u32x4*)(rowp + bj * HALF) = (u32x4){cvt_pk_bf16(v0[0], v0[1]), cvt_pk_bf16(v0[2], v0[3]), cvt_pk_bf16(v1[0], v1[1]), cvt_pk_bf16(v1[2], v1[3])}; } }
    }
};
struct EpiSwiGLU {
    static constexpr bool PERM = true;
    bf16_t* O; int ldc;
    __device__ __forceinline__ void operator()(const f32x4 (&acc)[2][2][4][2], const Unit& u, int wr, int wc, int fr, int fq) const {
        const int row0 = u.pm * BM + wr * 64 + fr, col0 = u.pn * HALF + wc * 32 + 8 * fq;
#pragma unroll
        for (int ai = 0; ai < 2; ++ai)
#pragma unroll
            for (int m = 0; m < 4; ++m) { bf16_t* rowp = O + (size_t)(row0 + ai * HALF + m * 16) * ldc + col0; unsigned w[4];
#pragma unroll
                for (int n = 0; n < 2; ++n) { const f32x4 g = acc[ai][0][m][n], up = acc[ai][1][m][n]; f32x4 v;
#pragma unroll
                    for (int e = 0; e < 4; ++e) v[e] = g[e] * up[e] * __builtin_amdgcn_rcpf(1.0f + __expf(-g[e]));
                    w[2 * n] = cvt_pk_bf16(v[0], v[1]); w[2 * n + 1] = cvt_pk_bf16(v[2], v[3]); }
                *(u32x4*)rowp = (u32x4){w[0], w[1], w[2], w[3]}; }
    }
};
struct EpiGLU {
    static constexpr bool PERM = true;
    bf16_t* O; int ldc; const float* bias; int halfN;
    __device__ __forceinline__ void operator()(const f32x4 (&acc)[2][2][4][2], const Unit& u, int wr, int wc, int fr, int fq) const {
        const int row0 = u.pm * BM + wr * 64 + fr, col0 = u.pn * HALF + wc * 32 + 8 * fq;
        f32x4 bv[2], bg[2];
#pragma unroll
        for (int n = 0; n < 2; ++n) { bv[n] = *(const f32x4*)(bias + col0 + 4 * n); bg[n] = *(const f32x4*)(bias + halfN + col0 + 4 * n); }
#pragma unroll
        for (int ai = 0; ai < 2; ++ai)
#pragma unroll
            for (int m = 0; m < 4; ++m) { bf16_t* rowp = O + (size_t)(row0 + ai * HALF + m * 16) * ldc + col0; unsigned w[4];
#pragma unroll
                for (int n = 0; n < 2; ++n) { const f32x4 a = acc[ai][0][m][n] + bv[n], g = acc[ai][1][m][n] + bg[n]; f32x4 v;
#pragma unroll
                    for (int e = 0; e < 4; ++e) v[e] = a[e] * __builtin_amdgcn_rcpf(1.0f + __expf(-g[e]));
                    w[2 * n] = cvt_pk_bf16(v[0], v[1]); w[2 * n + 1] = cvt_pk_bf16(v[2], v[3]); }
                *(u32x4*)rowp = (u32x4){w[0], w[1], w[2], w[3]}; }
    }
};
struct EpiS5State {
    static constexpr bool AFTER_DRAIN = true;
    __device__ __forceinline__ void fused(const f32x4 (&acc)[2][2][4][2], const Unit& u, int wr, int wc, int fr, int fq, LAS unsigned char* lds, int wid, int lane) const {
        LAS float* St = (LAS float*)lds;
#pragma unroll
        for (int ai = 0; ai < 2; ++ai)
#pragma unroll
            for (int m = 0; m < 4; ++m) { const int lr = ai * HALF + wr * 64 + m * 16 + fr;
#pragma unroll
                for (int n = 0; n < 2; ++n) *(LAS f32x4*)(St + lr * 128 + wc * 32 + n * 16 + 4 * fq) = acc[ai][0][m][n]; }
    }
};
struct EpiS5Out {
    const bf16_t* Aext; const float* dskip; bf16_t* Y;
    __device__ __forceinline__ void operator()(const f32x4 (&acc)[2][2][4][2], const Unit& u, int wr, int wc, int fr, int fq) const {
        const int row0 = u.pm * BM + wr * 64 + fr;
        const f32x4 dv = *(const f32x4*)(dskip + u.b * 16 + 4 * fq);
#pragma unroll
        for (int ai = 0; ai < 2; ++ai)
#pragma unroll
            for (int m = 0; m < 4; ++m) { const int row = row0 + ai * HALF + m * 16; const bf16_t* up = Aext + ((size_t)u.b * NCH + row) * AK + wc * 32 + 4 * fq;
#pragma unroll
                for (int bj = 0; bj < 2; ++bj)
#pragma unroll
                    for (int n = 0; n < 2; ++n) { const u32x2 uu = *(const u32x2*)(up + bj * HALF + n * 16); const f32x4 a = acc[ai][bj][m][n];
                        f32x4 v; v[0] = a[0] + dv[0] * bf_lo(uu.x); v[1] = a[1] + dv[1] * bf_hi(uu.x); v[2] = a[2] + dv[2] * bf_lo(uu.y); v[3] = a[3] + dv[3] * bf_hi(uu.y);
#pragma unroll
                        for (int e = 0; e < 4; ++e) { const float x = v[e], t = 1.5957691216057308f * (x + 0.044715f * x * x * x); v[e] = x * __builtin_amdgcn_rcpf(1.0f + __expf(-t)); }
                        const int i = 8 * bj + 2 * wc + n; u32x2 w; w.x = cvt_pk_bf16(v[0], v[1]); w.y = cvt_pk_bf16(v[2], v[3]);
                        *(u32x2*)(Y + (size_t)(row * 16 + i) * D + u.b * 16 + 4 * fq) = w; } }
    }
};


struct EpiResNorm {
    static constexpr bool AFTER_DRAIN = true, PERM = true;
    const bf16_t* hin; int hin_pitch; bf16_t* hout; int hout_pitch; float* hout_f; const float* g_post;
    bf16_t* out1; const float* g1; int mode1; bf16_t* out2; const float* g2;
    float* xch; unsigned* cnt; int inst;
    __device__ __forceinline__ void xpublish(const float (&part)[2][4], const Unit& u, int wr, int wc, int fr, int fq, LAS unsigned char* lds, int wid, int lane, int ex) const {
        LAS float* P = (LAS float*)lds;
        const int tid = wid * 64 + lane;
#pragma unroll
        for (int ai = 0; ai < 2; ++ai)
#pragma unroll
            for (int m = 0; m < 4; ++m) { float sq = part[ai][m]; sq += __shfl_xor(sq, 16); sq += __shfl_xor(sq, 32); if (fq == 0) P[(ai * HALF + wr * 64 + m * 16 + fr) * 4 + wc] = sq; }
        asm volatile("s_waitcnt lgkmcnt(0)" ::: "memory"); __builtin_amdgcn_s_barrier(); asm volatile("" ::: "memory");
        float* slots = xch + ((size_t)((inst * 2 + ex) * 64 + u.pm) * 256) * 4; unsigned* cw = cnt + ((inst * 2 + ex) * 64 + u.pm) * 64;
        if (tid < 256) { const float tot = (P[tid * 4] + P[tid * 4 + 1]) + (P[tid * 4 + 2] + P[tid * 4 + 3]); __hip_atomic_store(slots + tid * 4 + u.pn, tot, __ATOMIC_RELAXED, __HIP_MEMORY_SCOPE_AGENT); }
        asm volatile("s_waitcnt vmcnt(0)" ::: "memory");
        if (wid < 4 && lane == 0) __hip_atomic_fetch_add(cw, 1u, __ATOMIC_RELAXED, __HIP_MEMORY_SCOPE_AGENT);
    }
    __device__ __forceinline__ void xwait(const Unit& u, LAS unsigned char* lds, int wid, int lane, int ex) const {
        LAS float* S = (LAS float*)(lds + 4096);
        const int tid = wid * 64 + lane;
        float* slots = xch + ((size_t)((inst * 2 + ex) * 64 + u.pm) * 256) * 4; unsigned* cw = cnt + ((inst * 2 + ex) * 64 + u.pm) * 64;
        if (wid == 0) { unsigned sp = 0;
            while ((unsigned)__builtin_amdgcn_readfirstlane(__hip_atomic_load(cw, __ATOMIC_RELAXED, __HIP_MEMORY_SCOPE_AGENT)) < 16u) { __builtin_amdgcn_s_sleep(1); if (++sp > (1u << 22)) break; }
            __builtin_amdgcn_fence(__ATOMIC_ACQUIRE, "agent"); }
        asm volatile("s_waitcnt lgkmcnt(0)" ::: "memory"); __builtin_amdgcn_s_barrier(); asm volatile("" ::: "memory");
        if (tid < 256) { float t4 = 0.f;
#pragma unroll
            for (int t = 0; t < 4; ++t) t4 += __hip_atomic_load(slots + tid * 4 + t, __ATOMIC_RELAXED, __HIP_MEMORY_SCOPE_AGENT);
            S[tid] = 1.0f / sqrtf(t4 * (1.0f / D) + EPS); }
        asm volatile("s_waitcnt lgkmcnt(0)" ::: "memory"); __builtin_amdgcn_s_barrier(); asm volatile("" ::: "memory");
    }
    __device__ __forceinline__ void fused(f32x4 (&acc)[2][2][4][2], const Unit& u, int wr, int wc, int fr, int fq, LAS unsigned char* lds, int wid, int lane) const {
        const LAS float* S = (const LAS float*)(lds + 4096);
        const int col0 = u.pn * BM + wc * 32 + 8 * fq;
        float part[2][4];
#pragma unroll
        for (int ai = 0; ai < 2; ++ai)
#pragma unroll
            for (int m = 0; m < 4; ++m) { float sq = 0.f;
#pragma unroll
                for (int bj = 0; bj < 2; ++bj)
#pragma unroll
                    for (int n = 0; n < 2; ++n) { const f32x4 a = acc[ai][bj][m][n]; sq += (a[0] * a[0] + a[1] * a[1]) + (a[2] * a[2] + a[3] * a[3]); }
                part[ai][m] = sq; }
        xpublish(part, u, wr, wc, fr, fq, lds, wid, lane, 0);
        u32x4 ht[2][4][2];
#pragma unroll
        for (int ai = 0; ai < 2; ++ai)
#pragma unroll
            for (int m = 0; m < 4; ++m)
#pragma unroll
                for (int bj = 0; bj < 2; ++bj) ht[ai][m][bj] = *(const u32x4*)(hin + ((size_t)u.pm * BM + ai * HALF + wr * 64 + m * 16 + fr) * hin_pitch + col0 + bj * HALF);
        f32x4 gp[2][2];
#pragma unroll
        for (int bj = 0; bj < 2; ++bj)
#pragma unroll
            for (int n = 0; n < 2; ++n) gp[bj][n] = *(const f32x4*)(g_post + col0 + bj * HALF + 4 * n);
        xwait(u, lds, wid, lane, 0);
#pragma unroll
        for (int ai = 0; ai < 2; ++ai)
#pragma unroll
            for (int m = 0; m < 4; ++m) { const int lr = ai * HALF + wr * 64 + m * 16 + fr; const size_t row = (size_t)u.pm * BM + lr; const float rs = S[lr]; float sq = 0.f;
#pragma unroll
                for (int bj = 0; bj < 2; ++bj) { const int col = col0 + bj * HALF; const u32x4 t = ht[ai][m][bj];
                    f32x4 h0 = (f32x4){bf_lo(t.x), bf_hi(t.x), bf_lo(t.y), bf_hi(t.y)} + acc[ai][bj][m][0] * rs * gp[bj][0];
                    f32x4 h1 = (f32x4){bf_lo(t.z), bf_hi(t.z), bf_lo(t.w), bf_hi(t.w)} + acc[ai][bj][m][1] * rs * gp[bj][1];
                    if (hout_f) { *(f32x4*)(hout_f + row * D + col) = h0; *(f32x4*)(hout_f + row * D + col + 4) = h1; }
                    else { const u32x4 w = (u32x4){cvt_pk_bf16(h0[0], h0[1]), cvt_pk_bf16(h0[2], h0[3]), cvt_pk_bf16(h1[0], h1[1]), cvt_pk_bf16(h1[2], h1[3])}; *(u32x4*)(hout + row * hout_pitch + col) = w;
                        h0 = (f32x4){bf_lo(w.x), bf_hi(w.x), bf_lo(w.y), bf_hi(w.y)}; h1 = (f32x4){bf_lo(w.z), bf_hi(w.z), bf_lo(w.w), bf_hi(w.w)}; }
                    acc[ai][bj][m][0] = h0; acc[ai][bj][m][1] = h1;
                    sq += ((h0[0] * h0[0] + h0[1] * h0[1]) + (h0[2] * h0[2] + h0[3] * h0[3])) + ((h1[0] * h1[0] + h1[1] * h1[1]) + (h1[2] * h1[2] + h1[3] * h1[3])); }
                part[ai][m] = sq; }
        if (!out1) return;
        xpublish(part, u, wr, wc, fr, fq, lds, wid, lane, 1);
        xwait(u, lds, wid, lane, 1);
#pragma unroll
        for (int bj = 0; bj < 2; ++bj)
#pragma unroll
            for (int n = 0; n < 2; ++n) gp[bj][n] = *(const f32x4*)(g1 + col0 + bj * HALF + 4 * n);
#pragma unroll
        for (int ai = 0; ai < 2; ++ai)
#pragma unroll
            for (int m = 0; m < 4; ++m) { const int lr = ai * HALF + wr * 64 + m * 16 + fr; const int row = u.pm * BM + lr; const float rs = S[lr];
#pragma unroll
                for (int bj = 0; bj < 2; ++bj) { const int col = col0 + bj * HALF; const f32x4 a0 = acc[ai][bj][m][0], a1 = acc[ai][bj][m][1]; const f32x4 o0 = a0 * rs * gp[bj][0], o1 = a1 * rs * gp[bj][1];
                    bf16_t* p = mode1 ? out1 + ((size_t)((col >> 4) * NCH + (row >> 4)) * AK + (row & 15) * 16 + (col & 15)) : out1 + (size_t)row * D + col;
                    *(u32x4*)p = (u32x4){cvt_pk_bf16(o0[0], o0[1]), cvt_pk_bf16(o0[2], o0[3]), cvt_pk_bf16(o1[0], o1[1]), cvt_pk_bf16(o1[2], o1[3])}; } }
        if (out2) {
#pragma unroll
            for (int bj = 0; bj < 2; ++bj)
#pragma unroll
                for (int n = 0; n < 2; ++n) gp[bj][n] = *(const f32x4*)(g2 + col0 + bj * HALF + 4 * n);
#pragma unroll
            for (int ai = 0; ai < 2; ++ai)
#pragma unroll
                for (int m = 0; m < 4; ++m) { const int lr = ai * HALF + wr * 64 + m * 16 + fr; const size_t row = (size_t)u.pm * BM + lr; const float rs = S[lr];
#pragma unroll
                    for (int bj = 0; bj < 2; ++bj) { const int col = col0 + bj * HALF; const f32x4 o0 = acc[ai][bj][m][0] * rs * gp[bj][0], o1 = acc[ai][bj][m][1] * rs * gp[bj][1];
                        *(u32x4*)(out2 + row * D + col) = (u32x4){cvt_pk_bf16(o0[0], o0[1]), cvt_pk_bf16(o0[2], o0[3]), cvt_pk_bf16(o1[0], o1[1]), cvt_pk_bf16(o1[2], o1[3])}; } }
        }
    }
};

template <class T, class = void> struct epi_after_drain { static constexpr bool value = false; };
template <class T> struct epi_after_drain<T, decltype((void)T::AFTER_DRAIN)> { static constexpr bool value = T::AFTER_DRAIN; };
template <class Epi>
__device__ __forceinline__ void gemm_phase(LAS unsigned char* lds, const Gemm g, const Epi& E, int G, int c, int tid) {
    const int wid = __builtin_amdgcn_readfirstlane(tid >> 6), lane = tid & 63, wr = wid >> 2, wc = wid & 3, fr = lane & 15, fq = lane >> 4;
    const int nt = g.K / BK;
    unsigned voffA[2], voffB[2];
#pragma unroll
    for (int i = 0; i < 2; ++i) { int R, C; stage_rc(tid * 16 + i * 8192, R, C); voffA[i] = (unsigned)(R * g.lda + C) * 2u; const int Rb = epi_perm<Epi>::value ? ((R & ~31) + perm32(R & 31)) : R; voffB[i] = (unsigned)(Rb * g.ldb + C) * 2u; }
    constexpr unsigned kstep = BK * 2;
    const unsigned hA = (unsigned)HALF * g.lda * 2, hB = (unsigned)HALF * g.ldb * 2, tA = 2 * hA, tB = 2 * hB;
    const unsigned ldsw = (unsigned)wid * 1024u;
    const int aoff = lds_byte(wr * 64 + fr, fq * 8), boff = lds_byte(wc * 32 + fr, fq * 8);
#define PG8_SA(b, h) (((b) * 2 + (h)) * HTB)
#define PG8_SB(b, h) ((4 + (b) * 2 + (h)) * HTB)
#define PG8_STAGE(bufoff, gbase, voff) do { _Pragma("unroll") for (int _i = 0; _i < 2; ++_i) \
        __builtin_amdgcn_global_load_lds((const unsigned*)((const char*)(gbase) + (voff)[_i]), (LAS unsigned*)(lds + (bufoff) + ldsw + _i * 8192), 16, 0, 0); } while (0)
#define PG8_LDA(dst, b, h) do { _Pragma("unroll") for (int m = 0; m < 4; ++m) _Pragma("unroll") for (int k = 0; k < 2; ++k) dst[m][k] = *(const LAS bf16x8*)(lds + PG8_SA(b, h) + aoff + m * 2048 + k * 1024); } while (0)
#define PG8_LDB(dst, b, h) do { _Pragma("unroll") for (int n = 0; n < 2; ++n) _Pragma("unroll") for (int k = 0; k < 2; ++k) dst[n][k] = *(const LAS bf16x8*)(lds + PG8_SB(b, h) + boff + n * 2048 + k * 1024); } while (0)
#define PG8_MMA(ai, bj, At, Bt) do { __builtin_amdgcn_s_setprio(1); _Pragma("unroll") for (int m = 0; m < 4; ++m) _Pragma("unroll") for (int n = 0; n < 2; ++n) _Pragma("unroll") for (int k = 0; k < 2; ++k) \
        acc[ai][bj][m][n] = __builtin_amdgcn_mfma_f32_16x16x32_bf16(Bt[n][k], At[m][k], acc[ai][bj][m][n], 0, 0, 0); __builtin_amdgcn_s_setprio(0); } while (0)
#define PG8_WAIT_V(n) asm volatile("s_waitcnt vmcnt(" #n ")" ::: "memory")
#define PG8_WAIT_L(n) asm volatile("s_waitcnt lgkmcnt(" #n ")" ::: "memory")
#define PG8_BAR __builtin_amdgcn_s_barrier()
#define PG8_SCHED __builtin_amdgcn_sched_barrier(0)
    Order S; S.init(g.M, g.N, g.batch, G, c);
    Unit cur, nxt; int ui = 0;
    if (!S.next(0, cur)) return;
    f32x4 acc[2][2][4][2];
#pragma unroll
    for (int a = 0; a < 2; ++a)
#pragma unroll
        for (int b = 0; b < 2; ++b)
#pragma unroll
            for (int m = 0; m < 4; ++m)
#pragma unroll
                for (int n = 0; n < 2; ++n) acc[a][b][m][n] = (f32x4){0.f, 0.f, 0.f, 0.f};
    bf16x8 At[4][2], B0[2][2], B1[2][2];
    const char* cA = (const char*)g.A + ((unsigned)cur.b * g.bsA * 2u + (unsigned)cur.pm * tA); const char* cB = (const char*)g.Bt + ((unsigned)cur.b * g.bsB * 2u + (unsigned)cur.pn * tB);
    PG8_STAGE(PG8_SB(0, 0), cB, voffB); PG8_STAGE(PG8_SB(0, 1), cB + hB, voffB); PG8_STAGE(PG8_SA(0, 0), cA, voffA); PG8_STAGE(PG8_SA(0, 1), cA + hA, voffA);
    if (wr == 1) PG8_BAR;
    PG8_WAIT_V(2); PG8_BAR;
    PG8_STAGE(PG8_SB(1, 0), cB + kstep, voffB); PG8_STAGE(PG8_SA(1, 0), cA + kstep, voffA); PG8_STAGE(PG8_SB(1, 1), cB + hB + kstep, voffB);
    PG8_WAIT_V(6); PG8_BAR;
    for (;;) {
        const bool has_next = S.next(ui + 1, nxt);
        const char* nA = has_next ? (const char*)g.A + ((unsigned)nxt.b * g.bsA * 2u + (unsigned)nxt.pm * tA) : cA; const char* nB = has_next ? (const char*)g.Bt + ((unsigned)nxt.b * g.bsB * 2u + (unsigned)nxt.pn * tB) : cB;
        for (int t = 0; t < nt; t += 2) {
            const bool last = (t == nt - 2);
            const char* a1 = cA + (unsigned)(t + 1) * kstep;
            const char* a2 = last ? nA : cA + (unsigned)(t + 2) * kstep; const char* b2 = last ? nB : cB + (unsigned)(t + 2) * kstep;
            const char* a3 = a2 + kstep; const char* b3 = b2 + kstep;
            PG8_LDB(B0, 0, 0); PG8_LDB(B1, 0, 1); PG8_SCHED; PG8_LDA(At, 0, 0); PG8_STAGE(PG8_SA(1, 1), a1 + hA, voffA);
            PG8_WAIT_V(8); PG8_WAIT_L(0); PG8_BAR; PG8_MMA(0, 0, At, B0); PG8_MMA(0, 1, At, B1); PG8_BAR; PG8_SCHED;
            PG8_LDA(At, 0, 1); PG8_STAGE(PG8_SB(0, 0), b2, voffB); PG8_STAGE(PG8_SB(0, 1), b2 + hB, voffB); PG8_STAGE(PG8_SA(0, 0), a2, voffA);
            PG8_WAIT_V(8); PG8_WAIT_L(0); PG8_BAR; PG8_MMA(1, 0, At, B0); PG8_MMA(1, 1, At, B1); PG8_BAR; PG8_SCHED;
            PG8_LDB(B0, 1, 0); PG8_LDB(B1, 1, 1); PG8_SCHED; PG8_LDA(At, 1, 0); PG8_STAGE(PG8_SA(0, 1), a2 + hA, voffA);
            PG8_WAIT_V(8); PG8_WAIT_L(0); PG8_BAR; PG8_MMA(0, 0, At, B0); PG8_MMA(0, 1, At, B1); PG8_BAR; PG8_SCHED;
            PG8_LDA(At, 1, 1); PG8_STAGE(PG8_SB(1, 0), b3, voffB); PG8_STAGE(PG8_SB(1, 1), b3 + hB, voffB); PG8_STAGE(PG8_SA(1, 0), a3, voffA);
            PG8_WAIT_V(8); PG8_WAIT_L(0); PG8_BAR; PG8_MMA(1, 0, At, B0); PG8_MMA(1, 1, At, B1); PG8_BAR; PG8_SCHED;
        }
        constexpr bool AD = epi_after_drain<Epi>::value;
        if constexpr (!AD) { if (wr == 0) PG8_BAR;
            E(acc, cur, wr, wc, fr, fq); }
        if (!has_next) break;
#pragma unroll
        for (int a = 0; a < 2; ++a)
#pragma unroll
            for (int b = 0; b < 2; ++b)
#pragma unroll
                for (int m = 0; m < 4; ++m)
#pragma unroll
                    for (int n = 0; n < 2; ++n) acc[a][b][m][n] = (f32x4){0.f, 0.f, 0.f, 0.f};
        cur = nxt; cA = nA; cB = nB; ++ui;
        if constexpr (!epi_after_drain<Epi>::value) { if (wr == 1) PG8_BAR; }
    }
    PG8_WAIT_V(0);
    if constexpr (epi_after_drain<Epi>::value) { if (wr == 0) PG8_BAR; }
    PG8_BAR;
    if constexpr (epi_after_drain<Epi>::value) E.fused(acc, cur, wr, wc, fr, fq, lds, wid, lane);
#undef PG8_SA
#undef PG8_SB
#undef PG8_STAGE
#undef PG8_LDA
#undef PG8_LDB
#undef PG8_MMA
#undef PG8_WAIT_V
#undef PG8_WAIT_L
#undef PG8_BAR
#undef PG8_SCHED
}
}

__device__ __forceinline__ void transpose_item(const float* W, int K, int N, bf16_t* WT, int halfN, LAS unsigned short* scr, int item, int lane) {
    const int nblk = N / 64, kb = item / nblk, nb = item % nblk, k0 = 64 * kb, n0 = 64 * nb;
    int r0 = n0; if (halfN) r0 = n0 < halfN ? (n0 / 128) * 256 + (n0 % 128) : ((n0 - halfN) / 128) * 256 + 128 + ((n0 - halfN) % 128);
    const int lk = lane >> 4, ln = (lane & 15) * 4;
    f32x4 t[16];
#pragma unroll
    for (int i = 0; i < 16; ++i) t[i] = *(const f32x4*)(W + (size_t)(k0 + 4 * i + lk) * N + n0 + ln);
#pragma unroll
    for (int i = 0; i < 16; ++i) { u32x2 w; w.x = cvt_pk_bf16(t[i][0], t[i][1]); w.y = cvt_pk_bf16(t[i][2], t[i][3]);
        LAS unsigned* p = (LAS unsigned*)(scr + (4 * i + lk) * 66 + ln); p[0] = w.x; p[1] = w.y; }
    LDS_WAIT();
    const int c = lane & 7;
#pragma unroll
    for (int j = 0; j < 8; ++j) { const int n = (lane >> 3) + 8 * j; const LAS unsigned short* sp = scr + (8 * c) * 66 + n;
        u32x4 o; o.x = (unsigned)sp[0] | ((unsigned)sp[66] << 16); o.y = (unsigned)sp[2 * 66] | ((unsigned)sp[3 * 66] << 16); o.z = (unsigned)sp[4 * 66] | ((unsigned)sp[5 * 66] << 16); o.w = (unsigned)sp[6 * 66] | ((unsigned)sp[7 * 66] << 16);
        *(u32x4*)(WT + (size_t)(r0 + n) * K + k0 + 8 * c) = o; }
    LDS_WAIT();
}

constexpr int NR = 4;
__device__ __forceinline__ void rowpass(int gw, int NGW, int lane, const float* h_f32, float* hbuf, int hin_mode, int hout_mode, const bf16_t* add, const float* g_add,
                                        bf16_t* out1, const float* g1, int mode1, bf16_t* out2, const float* g2) {
    for (int row0 = gw * NR; row0 < L; row0 += NGW * NR) {
        f32x4 v[NR][4]; u32x2 av[NR][4];
        if (hin_mode == 0) {
#pragma unroll
            for (int r = 0; r < NR; ++r)
#pragma unroll
                for (int j = 0; j < 4; ++j) v[r][j] = ((const f32x4*)(h_f32 + (size_t)(row0 + r) * D))[64 * j + lane];
        } else {
#pragma unroll
            for (int r = 0; r < NR; ++r)
#pragma unroll
                for (int j = 0; j < 4; ++j) { const u32x2 t = ((const u32x2*)((const bf16_t*)hbuf + (size_t)(row0 + r) * 2 * D + D))[64 * j + lane]; v[r][j] = (f32x4){bf_lo(t.x), bf_hi(t.x), bf_lo(t.y), bf_hi(t.y)}; }
        }
        if (add) {
#pragma unroll
            for (int r = 0; r < NR; ++r)
#pragma unroll
                for (int j = 0; j < 4; ++j) av[r][j] = ((const u32x2*)(add + (size_t)(row0 + r) * D))[64 * j + lane];
            float ss[NR];
#pragma unroll
            for (int r = 0; r < NR; ++r) { float s_ = 0.f;
#pragma unroll
                for (int j = 0; j < 4; ++j) { const float a0 = bf_lo(av[r][j].x), a1 = bf_hi(av[r][j].x), a2 = bf_lo(av[r][j].y), a3 = bf_hi(av[r][j].y); s_ += (a0 * a0 + a1 * a1) + (a2 * a2 + a3 * a3); }
                ss[r] = s_; }
#pragma unroll
            for (int o = 1; o < 64; o <<= 1)
#pragma unroll
                for (int r = 0; r < NR; ++r) ss[r] += __shfl_xor(ss[r], o);
#pragma unroll
            for (int r = 0; r < NR; ++r) ss[r] = 1.0f / sqrtf(ss[r] * (1.0f / D) + EPS);
#pragma unroll
            for (int j = 0; j < 4; ++j) { const f32x4 gg = ((const f32x4*)g_add)[64 * j + lane];
#pragma unroll
                for (int r = 0; r < NR; ++r) { const f32x4 m = (f32x4){bf_lo(av[r][j].x), bf_hi(av[r][j].x), bf_lo(av[r][j].y), bf_hi(av[r][j].y)}; v[r][j] += m * ss[r] * gg; } }
        }
        if (hout_mode == 1) {
#pragma unroll
            for (int r = 0; r < NR; ++r)
#pragma unroll
                for (int j = 0; j < 4; ++j) { u32x2 w; w.x = cvt_pk_bf16(v[r][j][0], v[r][j][1]); w.y = cvt_pk_bf16(v[r][j][2], v[r][j][3]);
                    ((u32x2*)((bf16_t*)hbuf + (size_t)(row0 + r) * 2 * D + D))[64 * j + lane] = w; v[r][j] = (f32x4){bf_lo(w.x), bf_hi(w.x), bf_lo(w.y), bf_hi(w.y)}; }
        } else if (hout_mode == 2) {
#pragma unroll
            for (int r = 0; r < NR; ++r)
#pragma unroll
                for (int j = 0; j < 4; ++j) ((f32x4*)(hbuf + (size_t)(row0 + r) * D))[64 * j + lane] = v[r][j];
        }
        if (out1 || out2) {
            float ss[NR];
#pragma unroll
            for (int r = 0; r < NR; ++r) { float s_ = 0.f;
#pragma unroll
                for (int j = 0; j < 4; ++j) s_ += (v[r][j][0] * v[r][j][0] + v[r][j][1] * v[r][j][1]) + (v[r][j][2] * v[r][j][2] + v[r][j][3] * v[r][j][3]);
                ss[r] = s_; }
#pragma unroll
            for (int o = 1; o < 64; o <<= 1)
#pragma unroll
                for (int r = 0; r < NR; ++r) ss[r] += __shfl_xor(ss[r], o);
#pragma unroll
            for (int r = 0; r < NR; ++r) ss[r] = 1.0f / sqrtf(ss[r] * (1.0f / D) + EPS);
            if (out1) {
#pragma unroll
                for (int j = 0; j < 4; ++j) { const f32x4 gg = ((const f32x4*)g1)[64 * j + lane];
#pragma unroll
                    for (int r = 0; r < NR; ++r) { const f32x4 o = v[r][j] * ss[r] * gg; u32x2 w; w.x = cvt_pk_bf16(o[0], o[1]); w.y = cvt_pk_bf16(o[2], o[3]); const int row = row0 + r;
                        bf16_t* p = mode1 ? out1 + ((size_t)((16 * j + (lane >> 2)) * NCH + (row >> 4)) * AK + (row & 15) * 16 + 4 * (lane & 3)) : out1 + (size_t)row * D + 256 * j + 4 * lane;
                        *(u32x2*)p = w; } }
            }
            if (out2) {
#pragma unroll
                for (int j = 0; j < 4; ++j) { const f32x4 gg = ((const f32x4*)g2)[64 * j + lane];
#pragma unroll
                    for (int r = 0; r < NR; ++r) { const f32x4 o = v[r][j] * ss[r] * gg; u32x2 w; w.x = cvt_pk_bf16(o[0], o[1]); w.y = cvt_pk_bf16(o[2], o[3]);
                        *(u32x2*)(out2 + (size_t)(row0 + r) * D + 256 * j + 4 * lane) = w; } }
            }
        }
    }
}

__device__ __forceinline__ f32x2 cmul(f32x2 a, f32x2 b) { return (f32x2){a.x * b.x - a.y * b.y, a.x * b.y + a.y * b.x}; }
__device__ __forceinline__ void cpow_d(double are, double aim, double dt, double n, double& re, double& im) {
    const double mag = exp(are * dt * n), ang = aim * dt * n;
    const double k = rint(ang * 0.15915494309189535), r = (ang - k * 6.283185307179586) - k * 2.4492935982947064e-16, r2 = r * r;
    double s = 0.0, ts = r, cc = 0.0, tc = 1.0;
#pragma unroll
    for (int q = 0; q < 16; ++q) { s += ts; cc += tc; ts *= -r2 * (1.0 / (double)((2 * q + 2) * (2 * q + 3))); tc *= -r2 * (1.0 / (double)((2 * q + 1) * (2 * q + 2))); }
    re = mag * cc; im = mag * s;
}
struct S5In { const float *log_dt, *a_re, *a_im, *b_re, *b_im, *c_re, *c_im; };
__device__ __forceinline__ void s5_precompute(LAS unsigned char* lds, const S5In& in, int l, int g, bf16_t* BT3, bf16_t* W1T, float* SC, int tid) {
    LAS f32x2* LP = (LAS f32x2*)lds;
    LAS f32x2* BB = LP + 17 * 64;
    LAS f32x2* CC = BB + 64 * 16;
    LAS float* KT = (LAS float*)(CC + 16 * 64);
    const int lg = l * NG + g;
    LAS f32x2* LS = (LAS f32x2*)(KT + 4096);
    {
        const int p = tid & 63, dg = tid >> 6;
        const double dt = exp((double)in.log_dt[lg]), are = (double)in.a_re[lg * 64 + p], aim = (double)in.a_im[lg * 64 + p];
        for (int d = dg; d <= 16; d += 8) { double re, im; cpow_d(are, aim, dt, (double)d, re, im); LP[d * 64 + p] = (f32x2){(float)re, (float)im}; }
        if (dg == 7) { double re, im; cpow_d(are, aim, dt, 512.0, re, im); LS[p] = (f32x2){(float)re, (float)im}; }
        if (dg == 6) {
            double lr, li; cpow_d(are, aim, dt, 1.0, lr, li);
            const double nr = lr - 1.0, ni = li, den = are * are + aim * aim;
            const double fr_ = (nr * are + ni * aim) / den, fi_ = (ni * are - nr * aim) / den;
            for (int c = 0; c < 16; ++c) { const double br = (double)in.b_re[(size_t)(lg * 64 + p) * 16 + c], bi = (double)in.b_im[(size_t)(lg * 64 + p) * 16 + c];
                BB[p * 16 + c] = (f32x2){(float)(fr_ * br - fi_ * bi), (float)(fr_ * bi + fi_ * br)}; }
        }
    }
    for (int idx = tid; idx < 1024; idx += 512) { const int c = idx >> 6, p = idx & 63; CC[c * 64 + p] = (f32x2){in.c_re[(size_t)(lg * 16 + c) * 64 + p], in.c_im[(size_t)(lg * 16 + c) * 64 + p]}; }
    __syncthreads();
    if (tid < 64) { const f32x2 lt = LP[16 * 64 + tid], ls = LS[tid]; *(f32x4*)(SC + (size_t)(lg * 64 + tid) * 4) = (f32x4){lt.x, lt.y, ls.x, ls.y}; }
    for (int idx = tid; idx < 4096; idx += 512) { const int d = idx >> 8, c = (idx >> 4) & 15, c2 = idx & 15; float s = 0.f;
        for (int p = 0; p < 64; ++p) { const f32x2 t = cmul(CC[c * 64 + p], LP[d * 64 + p]); const f32x2 b = BB[p * 16 + c2]; s += t.x * b.x - t.y * b.y; }
        KT[idx] = s; }
    __syncthreads();
    bf16_t* bt3 = BT3 + (size_t)lg * 256 * AK;
    for (int ch = tid; ch < 256 * 48; ch += 512) { const int n = ch / 48, kc = ch % 48, k0 = kc * 8, i = n >> 4, c = n & 15; float v[8];
        if (k0 < 256) { const int j = k0 >> 4, c0 = k0 & 15;
#pragma unroll
            for (int e = 0; e < 8; ++e) v[e] = (i >= j) ? KT[((i - j) * 16 + c) * 16 + c0 + e] : 0.f;
        } else { const int p0 = (k0 - 256) >> 1;
#pragma unroll
            for (int e = 0; e < 4; ++e) { const f32x2 t = cmul(CC[c * 64 + p0 + e], LP[(i + 1) * 64 + p0 + e]); v[2 * e] = t.x; v[2 * e + 1] = -t.y; } }
        *(u32x4*)(bt3 + (size_t)n * AK + k0) = (u32x4){cvt_pk_bf16(v[0], v[1]), cvt_pk_bf16(v[2], v[3]), cvt_pk_bf16(v[4], v[5]), cvt_pk_bf16(v[6], v[7])}; }
    bf16_t* w1t = W1T + (size_t)lg * 128 * 256;
    for (int ch = tid; ch < 128 * 32; ch += 512) { const int n = ch >> 5, kc = ch & 31, k0 = kc * 8, p = n >> 1, ri = n & 1, j = k0 >> 4, c0 = k0 & 15; float v[8];
#pragma unroll
        for (int e = 0; e < 8; ++e) { const f32x2 t = cmul(LP[(15 - j) * 64 + p], BB[p * 16 + c0 + e]); v[e] = ri ? t.y : t.x; }
        *(u32x4*)(w1t + (size_t)n * 256 + k0) = (u32x4){cvt_pk_bf16(v[0], v[1]), cvt_pk_bf16(v[2], v[3]), cvt_pk_bf16(v[4], v[5]), cvt_pk_bf16(v[6], v[7])}; }
    __syncthreads();
}

__device__ __forceinline__ void s5_scan(LAS unsigned char* lds, const float* S, const float* SC, bf16_t* Aext, float* xq, unsigned* cq, int l, int G, int c, int tid) {
    const int p = tid & 63, seg = tid >> 6, lane = tid & 63;
    LAS f32x2* E = (LAS f32x2*)(lds + 131072 + 512);
    for (int u = c; u < 256; u += G) {
        const int g = (G == 256) ? (u & 7) * 8 + (u >> 5) : (u >> 2), q = (G == 256) ? (u >> 3) & 3 : (u & 3);
        const f32x4 k4 = *(const f32x4*)(SC + (size_t)((l * NG + g) * 64 + p) * 4);
        const f32x2 lamT = (f32x2){k4[0], k4[1]}, lamS = (f32x2){k4[2], k4[3]};
        f32x2 lamQ = lamS;
#pragma unroll
        for (int i = 0; i < 3; ++i) lamQ = cmul(lamQ, lamQ);
        const LAS float* sp = (const LAS float*)lds + (seg * 32) * 128 + 2 * p;
        f32x2 sv[32];
#pragma unroll
        for (int kk = 0; kk < 32; ++kk) sv[kk] = *(const LAS f32x2*)(sp + kk * 128);
        f32x2 e = (f32x2){0.f, 0.f};
#pragma unroll
        for (int kk = 0; kk < 32; ++kk) e = cmul(lamT, e) + sv[kk];
        E[seg * 64 + p] = e;
        __syncthreads();
        float* slots = xq + (size_t)((l * NG + g) * 4) * 128; unsigned* cw = cq + (l * NG + g) * 64;
        if (seg == 0) {
            f32x2 t = (f32x2){0.f, 0.f};
#pragma unroll
            for (int s2 = 0; s2 < 8; ++s2) t = cmul(lamS, t) + E[s2 * 64 + p];
            __hip_atomic_store(slots + q * 128 + 2 * p, t.x, __ATOMIC_RELAXED, __HIP_MEMORY_SCOPE_AGENT);
            __hip_atomic_store(slots + q * 128 + 2 * p + 1, t.y, __ATOMIC_RELAXED, __HIP_MEMORY_SCOPE_AGENT);
            asm volatile("s_waitcnt vmcnt(0)" ::: "memory");
            if (lane == 0) __hip_atomic_fetch_add(cw, 1u, __ATOMIC_RELAXED, __HIP_MEMORY_SCOPE_AGENT);
            unsigned spn = 0;
            while ((unsigned)__builtin_amdgcn_readfirstlane(__hip_atomic_load(cw, __ATOMIC_RELAXED, __HIP_MEMORY_SCOPE_AGENT)) < 4u) { __builtin_amdgcn_s_sleep(1); if (++spn > (1u << 22)) break; }
            __builtin_amdgcn_fence(__ATOMIC_ACQUIRE, "agent");
            f32x2 cin = (f32x2){0.f, 0.f};
            for (int q2 = 0; q2 < q; ++q2) { const f32x2 tq = (f32x2){__hip_atomic_load(slots + q2 * 128 + 2 * p, __ATOMIC_RELAXED, __HIP_MEMORY_SCOPE_AGENT), __hip_atomic_load(slots + q2 * 128 + 2 * p + 1, __ATOMIC_RELAXED, __HIP_MEMORY_SCOPE_AGENT)};
                cin = cmul(lamQ, cin) + tq; }
            E[8 * 64 + p] = cin;
        }
        __syncthreads();
        f32x2 x = E[8 * 64 + p];
        for (int s2 = 0; s2 < seg; ++s2) x = cmul(lamS, x) + E[s2 * 64 + p];
        bf16_t* xp = Aext + ((size_t)g * NCH + q * 256 + seg * 32) * AK + 256 + 2 * p;
#pragma unroll
        for (int kk = 0; kk < 32; ++kk) { *(unsigned*)(xp + (size_t)kk * AK) = cvt_pk_bf16(x.x, x.y); x = cmul(lamT, x) + sv[kk]; }
        asm volatile("s_waitcnt vmcnt(0)" ::: "memory");
        __syncthreads();
    }
}

template <bool DIAGB>
__device__ __forceinline__ bool attn_block(LAS unsigned char* ldsK, LAS unsigned char* ldsV, const bf16x8 (&qf)[2], f32x4 (&oacc)[4], float& log_rest, int w, int fr, int fq, int ql, int bp16, int bp32) {
    int lim = ql; asm volatile("" : "+v"(lim));
    float base = log_rest;
    bool done = false;
#pragma unroll
    for (int ks = 3; ks >= 0; --ks) {
        if ((!DIAGB || 2 * ks <= w) && !done) {
            f32x4 z[2], l1[2]; float Gs[2];
#pragma unroll
            for (int t = 0; t < 2; ++t) { const int n = 2 * ks + t;
                z[t] = (f32x4){0.f, 0.f, 0.f, 0.f};
#pragma unroll
                for (int kk = 0; kk < 2; ++kk) { const bf16x8 a = *(const LAS bf16x8*)(ldsK + (16 * n + fr) * 144 + (32 * kk + 8 * fq) * 2); z[t] = __builtin_amdgcn_mfma_f32_16x16x32_bf16(a, qf[kk], z[t], 0, 0, 0); }
#pragma unroll
                for (int r = 0; r < 4; ++r) { const float zz = z[t][r], sp = __builtin_amdgcn_logf(1.0f + __builtin_amdgcn_exp2f(-fabsf(zz))); const float mn = __builtin_amdgcn_fmed3f(zz, 0.f, -3.0e38f); const float lb = mn - sp; float lm = lb - zz;
                    if (DIAGB) { const bool valid = (16 * n + 4 * fq + r) < lim; lm = valid ? lm : 0.f; }
                    z[t][r] = lb; l1[t][r] = lm; }
                Gs[t] = (l1[t][0] + l1[t][1]) + (l1[t][2] + l1[t][3]); }
            unsigned pk[2][2];
#pragma unroll
            for (int t = 1; t >= 0; --t) { const int n = 2 * ks + t;
                const float g0 = Gs[t], p = __builtin_bit_cast(float, __builtin_amdgcn_ds_bpermute(bp16, __builtin_bit_cast(int, g0))), tt = g0 + p;
                const float q = __builtin_bit_cast(float, __builtin_amdgcn_ds_bpermute(bp32, __builtin_bit_cast(int, tt)));
                const float Tn = tt + q, sfx = ((fq & 1) ? 0.f : p) + ((fq < 2) ? q : 0.f);
                const float b0 = base + sfx;
                const float lt3 = b0, lt2 = b0 + l1[t][3], lt1 = lt2 + l1[t][2], lt0 = lt1 + l1[t][1];
                float w0 = __builtin_amdgcn_exp2f(z[t][0] + lt0), w1 = __builtin_amdgcn_exp2f(z[t][1] + lt1), w2 = __builtin_amdgcn_exp2f(z[t][2] + lt2), w3 = __builtin_amdgcn_exp2f(z[t][3] + lt3);
                if (DIAGB) { const int kb = 16 * n + 4 * fq; w0 = (kb + 0 < lim) ? w0 : 0.f; w1 = (kb + 1 < lim) ? w1 : 0.f; w2 = (kb + 2 < lim) ? w2 : 0.f; w3 = (kb + 3 < lim) ? w3 : 0.f; }
                pk[t][0] = cvt_pk_bf16(w0, w1); pk[t][1] = cvt_pk_bf16(w2, w3);
                base += Tn; }
            const u32x4 bwv = (u32x4){pk[0][0], pk[0][1], pk[1][0], pk[1][1]};
            const bf16x8 bw = __builtin_bit_cast(bf16x8, bwv);
#pragma unroll
            for (int nt = 0; nt < 4; ++nt) { const LAS unsigned char* vp = ldsV + (16 * nt + fr) * 272 + (32 * ks + 4 * fq) * 2;
                const s16x4 lo = *(const LAS s16x4*)vp, hi = *(const LAS s16x4*)(vp + 32);
                const bf16x8 a = __builtin_shufflevector(lo, hi, 0, 1, 2, 3, 4, 5, 6, 7);
                oacc[nt] = __builtin_amdgcn_mfma_f32_16x16x32_bf16(a, bw, oacc[nt], 0, 0, 0); }
            if ((ks & 1) == 0) done = __all(base <= -150.1f) != 0;
        }
    }
    log_rest = base;
    return done;
}

__device__ __forceinline__ void attn_phase(LAS unsigned char* lds, const bf16_t* Q, const bf16_t* Kb, const bf16_t* Vt, bf16_t* O, int G, int c, int tid) {
    const int w = __builtin_amdgcn_readfirstlane(tid >> 6), lane = tid & 63, fr = lane & 15, fq = lane >> 4;
    const int bp16 = (lane ^ 16) << 2, bp32 = (lane ^ 32) << 2;
    LAS unsigned char* ldsK = lds; LAS unsigned char* ldsV = lds + 18432; volatile LAS int* flags = (volatile LAS int*)(lds + 35840);
    for (int u = c; u < 2048; u += G) {
        const int h = u & 15, qb = u >> 4, ql = 16 * w + fr;
        const size_t qrow = (size_t)qb * 128 + ql;
        bf16x8 qf[2];
#pragma unroll
        for (int ks = 0; ks < 2; ++ks) qf[ks] = *(const bf16x8*)(Q + qrow * D + h * 64 + 32 * ks + 8 * fq);
        f32x4 oacc[4];
#pragma unroll
        for (int i = 0; i < 4; ++i) oacc[i] = (f32x4){0.f, 0.f, 0.f, 0.f};
        float log_rest = 0.f; int mydone = 0;
        const int skey0 = tid >> 3, sch0 = tid & 7, sd0 = tid >> 4, sch1 = tid & 15;
        const bf16_t* kp = Kb + (size_t)skey0 * D + h * 64 + sch0 * 8;
        const bf16_t* vp0 = Vt + (size_t)(h * 64 + sd0) * L + sch1 * 8;
        u32x4 pk0 = *(const u32x4*)(kp + (size_t)128 * qb * D), pk1 = *(const u32x4*)(kp + (size_t)(128 * qb + 64) * D);
        u32x4 pv0 = *(const u32x4*)(vp0 + 128 * qb), pv1 = *(const u32x4*)(vp0 + (size_t)32 * L + 128 * qb);
        for (int j = qb; j >= 0; --j) {
            __syncthreads();
            if (j < qb) { int all = 1;
#pragma unroll
                for (int i = 0; i < 8; ++i) all &= flags[i];
                if (all && !DIAG_NOEXIT) break; }
            *(LAS u32x4*)(ldsK + skey0 * 144 + sch0 * 16) = pk0; *(LAS u32x4*)(ldsK + (skey0 + 64) * 144 + sch0 * 16) = pk1;
            *(LAS u32x4*)(ldsV + sd0 * 272 + sch1 * 16) = pv0;   *(LAS u32x4*)(ldsV + (sd0 + 32) * 272 + sch1 * 16) = pv1;
            __syncthreads();
            if (j > 0) { const int jn = j - 1;
                pk0 = *(const u32x4*)(kp + (size_t)128 * jn * D); pk1 = *(const u32x4*)(kp + (size_t)(128 * jn + 64) * D);
                pv0 = *(const u32x4*)(vp0 + 128 * jn); pv1 = *(const u32x4*)(vp0 + (size_t)32 * L + 128 * jn); }
            if (!mydone) {
            bool dn;
            if (j == qb) dn = attn_block<true>(ldsK, ldsV, qf, oacc, log_rest, w, fr, fq, ql, bp16, bp32); else dn = attn_block<false>(ldsK, ldsV, qf, oacc, log_rest, w, fr, fq, ql, bp16, bp32);
            mydone = dn ? 1 : 0;
            if (lane == 0) flags[w] = mydone;
            }
        }
#pragma unroll
        for (int nt = 0; nt < 4; ++nt) { u32x2 o; o.x = cvt_pk_bf16(oacc[nt][0], oacc[nt][1]); o.y = cvt_pk_bf16(oacc[nt][2], oacc[nt][3]);
            *(u32x2*)(O + qrow * D + h * 64 + 16 * nt + 4 * fq) = o; }
    }
}


#define XB_TMO      128
#define XB_XCNT(j)  (256  + 64 * (j))
#define XB_XSUB(j)  (1280 + 64 * (j))
#define XB_XGEN(j)  (2304 + 64 * (j))
#define XB_TOP      3328
#define XB_TOPGEN   3392
#define XCD_BAR_WORDS 3456
#define XB_SPIN_CAP (1u << 18)
__device__ __forceinline__ unsigned xb_ld(unsigned* p)              { return __hip_atomic_load(p, __ATOMIC_RELAXED, __HIP_MEMORY_SCOPE_AGENT); }
__device__ __forceinline__ unsigned xb_add(unsigned* p, unsigned v) { return __hip_atomic_fetch_add(p, v, __ATOMIC_RELAXED, __HIP_MEMORY_SCOPE_AGENT); }
__device__ __forceinline__ unsigned xb_xcc_id() { return (unsigned)__builtin_amdgcn_s_getreg((3 << 11) | 20) & 0xFu; }
#define XB_SPIN(cond, bar) do { unsigned _sp = 0; while (cond) { __builtin_amdgcn_s_sleep(1); \
    if ((++_sp & 255u) == 0u) { if (xb_ld(&(bar)[XB_TMO])) break; if (_sp > XB_SPIN_CAP) { atomicAdd(&(bar)[XB_TMO], 1u); break; } } } } while (0)
struct XcdBarrier { unsigned* bar; unsigned x; volatile LAS unsigned* st; };
__device__ __forceinline__ XcdBarrier xcd_barrier_post(unsigned* bar, volatile LAS unsigned* st) {
    XcdBarrier b; b.bar = bar; b.x = xb_xcc_id(); b.st = st;
    if (threadIdx.x == 0) (void)xb_add(&bar[XB_XCNT(b.x)], 1u);
    return b;
}
__device__ __forceinline__ void xcd_barrier_complete(unsigned* bar, unsigned x, unsigned& nloc, unsigned& nx) {
    const unsigned G = gridDim.x * gridDim.y * gridDim.z;
    unsigned sum, cnt, mine, sp = 0u;
    for (;;) {
        sum = 0u; cnt = 0u; mine = 0u;
#pragma unroll
        for (unsigned j = 0; j < 16; ++j) { const unsigned c = xb_ld(&bar[XB_XCNT(j)]); sum += c; cnt += (c > 0u) ? 1u : 0u; mine = (j == x) ? c : mine; }
        if (sum == G) break;
        __builtin_amdgcn_s_sleep(1);
        if ((++sp & 255u) == 0u) { if (xb_ld(&bar[XB_TMO])) break; if (sp > XB_SPIN_CAP) { atomicAdd(&bar[XB_TMO], 1u); break; } }
    }
    nloc = mine > 0u ? mine : 1u; nx = cnt > 0u ? cnt : 1u;
}
__device__ __forceinline__ void xcd_barrier(const XcdBarrier& b) {
    asm volatile("s_waitcnt vmcnt(0)" ::: "memory");
    __syncthreads();
    if (threadIdx.x == 0) {
        unsigned* bar = b.bar;
        __builtin_amdgcn_s_waitcnt(0);
        unsigned nloc = b.st[0], nx = b.st[1];
        if (nloc == 0u) { xcd_barrier_complete(bar, b.x, nloc, nx); b.st[0] = nloc; b.st[1] = nx; }
        const unsigned old = xb_add(&bar[XB_XSUB(b.x)], 1u);
        const unsigned gen = old / nloc;
        if (old + 1u == (gen + 1u) * nloc) {
            __builtin_amdgcn_fence(__ATOMIC_RELEASE, "agent");
            asm volatile("s_waitcnt vmcnt(0)" ::: "memory");
            const unsigned og = xb_add(&bar[XB_TOP], 1u);
            const unsigned tg = og / nx;
            if (og + 1u == (tg + 1u) * nx) xb_add(&bar[XB_TOPGEN], 1u);
            else XB_SPIN(xb_ld(&bar[XB_TOPGEN]) == tg, bar);
            __builtin_amdgcn_fence(__ATOMIC_ACQUIRE, "agent");
            xb_add(&bar[XB_XGEN(b.x)], 1u);
            asm volatile("s_waitcnt vmcnt(0)" ::: "memory");
        } else {
            XB_SPIN(xb_ld(&bar[XB_XGEN(b.x)]) == gen, bar);
            __builtin_amdgcn_fence(__ATOMIC_ACQUIRE, "agent");
            asm volatile("s_waitcnt vmcnt(0)" ::: "memory");
        }
    }
    __syncthreads();
}

__device__ __forceinline__ float bf1(const bf16_t* p) { return __uint_as_float(((unsigned)*p) << 16); }
__device__ __forceinline__ float wave_max(float v) {
#pragma unroll
    for (int o = 1; o < 64; o <<= 1) v = fmaxf(v, __shfl_xor(v, o));
    return v;
}
__device__ __forceinline__ void diag_s5(const S5In& in, const float* dskip, const bf16_t* Aext, const bf16_t* Y, float* res, int tid) {
    if (tid < 64) {
        const int p = tid, g = 5, lg = g;
        const double dtd = exp((double)in.log_dt[lg]), are = (double)in.a_re[lg * 64 + p], aim = (double)in.a_im[lg * 64 + p];
        double lr, li; cpow_d(are, aim, dtd, 1.0, lr, li);
        const double nr = lr - 1.0, ni = li, den = are * are + aim * aim;
        const double fr_ = (nr * are + ni * aim) / den, fi_ = (ni * are - nr * aim) / den;
        const f32x2 lam = (f32x2){(float)lr, (float)li};
        f32x2 bb[16], cc[16]; float dd[16];
#pragma unroll
        for (int c = 0; c < 16; ++c) { const double br = (double)in.b_re[(size_t)(lg * 64 + p) * 16 + c], bi = (double)in.b_im[(size_t)(lg * 64 + p) * 16 + c];
            bb[c] = (f32x2){(float)(fr_ * br - fi_ * bi), (float)(fr_ * bi + fi_ * br)};
            cc[c] = (f32x2){in.c_re[(size_t)(lg * 16 + c) * 64 + p], in.c_im[(size_t)(lg * 16 + c) * 64 + p]}; dd[c] = dskip[g * 16 + c]; }
        f32x2 x = (f32x2){0.f, 0.f}; float maxd = 0.f, maxa = 0.f;
        for (int t = 0; t < 2048; ++t) {
            const bf16_t* up = Aext + ((size_t)(g * NCH + (t >> 4)) * AK + (t & 15) * 16);
            const u32x4 u0 = *(const u32x4*)up, u1 = *((const u32x4*)up + 1);
            float uu[16] = {bf_lo(u0.x), bf_hi(u0.x), bf_lo(u0.y), bf_hi(u0.y), bf_lo(u0.z), bf_hi(u0.z), bf_lo(u0.w), bf_hi(u0.w), bf_lo(u1.x), bf_hi(u1.x), bf_lo(u1.y), bf_hi(u1.y), bf_lo(u1.z), bf_hi(u1.z), bf_lo(u1.w), bf_hi(u1.w)};
            f32x2 bu = (f32x2){0.f, 0.f};
#pragma unroll
            for (int c = 0; c < 16; ++c) bu += bb[c] * uu[c];
            x = cmul(lam, x) + bu;
#pragma unroll
            for (int c = 0; c < 16; ++c) { float yc = cc[c].x * x.x - cc[c].y * x.y; yc = wave_sum(yc); yc += dd[c] * uu[c];
                const float tt = 1.5957691216057308f * (yc + 0.044715f * yc * yc * yc); yc = yc / (1.0f + expf(-tt));
                const float got = bf1(Y + (size_t)t * D + g * 16 + c); maxd = fmaxf(maxd, fabsf(yc - got)); maxa = fmaxf(maxa, fabsf(yc)); }
        }
        if (p == 0) res[0] = maxd / maxa;
    }
}
__device__ __forceinline__ void diag_attn(const bf16_t* Q, const bf16_t* Kb, const bf16_t* Vt, const bf16_t* O, float* res, int tid) {
    const int w = tid >> 6, d = tid & 63;
    const int t = 40 * 128 + (w == 0 ? 0 : w == 1 ? 15 : w == 2 ? 16 : w == 3 ? 64 : w == 4 ? 100 : w == 5 ? 120 : w == 6 ? 125 : 127), h = 3;
    const float q = bf1(Q + (size_t)t * D + h * 64 + d);
    float acc = 0.f, o = 0.f; const int s_lo = t - 600 > 0 ? t - 600 : 0;
    for (int s = t - 1; s >= s_lo; --s) { const float z = wave_sum(q * bf1(Kb + (size_t)s * D + h * 64 + d)); const float sp = logf(1.0f + expf(-fabsf(z))), lb = fminf(z, 0.f) - sp;
        const float wgt = expf(lb + acc); acc += lb - z; o += wgt * bf1(Vt + (size_t)(h * 64 + d) * L + s); }
    const float got = bf1(O + (size_t)t * D + h * 64 + d);
    const float dd = wave_max(fabsf(o - got)), aa = wave_max(fabsf(o));
    if (d == 0) res[1 + w] = dd / aa;
}
__device__ __forceinline__ float digit_of(float err) { float dgt = -2.0f * log10f(fmaxf(err, 1e-6f)); return fminf(fmaxf(rintf(dgt), 0.f), 9.f); }

struct Args { const float* in[22]; float* out; unsigned char* ws; int ph_lo, ph_hi; };

__global__ void __launch_bounds__(512, 2) mk_fwd(Args a) {
    extern __shared__ __attribute__((aligned(16))) unsigned char lds_raw[];
    LAS unsigned char* lds = (LAS unsigned char*)lds_raw;
    cg::grid_group grid = cg::this_grid();
    volatile LAS unsigned* xst = (volatile LAS unsigned*)(lds + 131072 + 64);
    if (threadIdx.x < 2) xst[threadIdx.x] = 0u;
    __syncthreads();
    const XcdBarrier xbar = xcd_barrier_post((unsigned*)a.ws, xst);
    const int G0 = gridDim.x, c0 = blockIdx.x;
    typedef const __attribute__((address_space(4))) Args* KArgs;
    const int lo = a.ph_lo, hi = a.ph_hi; (void)lo; (void)hi;
    int ph = 0; (void)ph;
#if DIAG == 3
    unsigned long long t0_ = __builtin_amdgcn_s_memrealtime(), tacc = 0; int cur_group = 0;
#define GRP(g) cur_group = (g);
#else
#define GRP(g)
#endif
#if MK_ONE_LAUNCH
#define PH_COND true
#define PH_SYNC(last) if (!(last)) { if (USE_CG_SYNC) grid.sync(); else xcd_barrier(xbar); }
#else
#define PH_COND (ph >= lo && ph < hi)
#define PH_SYNC(last)
#endif
#define PH_BEGIN if (PH_COND) { int tid = threadIdx.x; asm volatile("" : "+v"(tid)); int c = c0, G = G0; asm volatile("" : "+s"(c), "+s"(G)); const int NGW = G * 8; (void)NGW; const int lane = tid & 63, wave = __builtin_amdgcn_readfirstlane(tid >> 6), gw = c * 8 + wave; (void)lane; (void)gw; \
    KArgs ap = (KArgs)__builtin_amdgcn_kernarg_segment_ptr(); asm volatile("" : "+s"(ap)); unsigned char* ws = ap->ws; float* out = ap->out; const float* x = ap->in[0]; (void)out; (void)x; \
    bf16_t* WIN = (bf16_t*)(ws + WS_WIN); bf16_t* WOUT = (bf16_t*)(ws + WS_WOUT); bf16_t* WGLU = (bf16_t*)(ws + WS_WGLU); \
    bf16_t* WK = (bf16_t*)(ws + WS_WK); bf16_t* WV = (bf16_t*)(ws + WS_WV); bf16_t* WQ = (bf16_t*)(ws + WS_WQ); bf16_t* WO = (bf16_t*)(ws + WS_WO); \
    bf16_t* BT3 = (bf16_t*)(ws + WS_BT3); bf16_t* W1T = (bf16_t*)(ws + WS_W1T); float* SC = (float*)(ws + WS_SC); \
    bf16_t* AEXT = (bf16_t*)(ws + WS_AEXT); float* Sb = (float*)(ws + WS_S); bf16_t* ACT = (bf16_t*)(ws + WS_ACT); bf16_t* MIX = (bf16_t*)(ws + WS_MIX); \
    bf16_t* VT = (bf16_t*)(ws + WS_VT); bf16_t* KB = (bf16_t*)(ws + WS_KB); bf16_t* Yb = (bf16_t*)(ws + WS_Y); bf16_t* Qb = (bf16_t*)(ws + WS_Q); bf16_t* Ob = (bf16_t*)(ws + WS_O); bf16_t* HK = (bf16_t*)(ws + WS_HK); \
    (void)WIN; (void)WOUT; (void)WGLU; (void)WK; (void)WV; (void)WQ; (void)WO; (void)BT3; (void)W1T; (void)SC; (void)AEXT; (void)Sb; (void)ACT; (void)MIX; (void)VT; (void)KB; (void)Yb; (void)Qb; (void)Ob; (void)HK;
#if DIAG == 3
#define PH_STAMP { const unsigned long long t1_ = __builtin_amdgcn_s_memrealtime(); if (cur_group == DIAG_GROUP) tacc += t1_ - t0_; t0_ = t1_; }
#else
#define PH_STAMP
#endif
#define PH_END   PH_SYNC(false) PH_STAMP } ++ph;
#define PH_END_CG   if (lo == 0x7fffffff) grid.sync();   xcd_barrier(xbar); } ++ph;
#define PH_END_LAST(last)   PH_SYNC(last) PH_STAMP } ++ph;

    DUPFOR(0) PH_BEGIN
        if (c < 128) { S5In in{ap->in[7], ap->in[8], ap->in[9], ap->in[10], ap->in[11], ap->in[12], ap->in[13]}; s5_precompute(lds, in, c >> 6, c & 63, BT3, W1T, SC, tid); }
        LAS unsigned short* scr = (LAS unsigned short*)(lds + wave * 16384);
        constexpr int I_IN = 16 * 88, I_OUT = 44 * 16, I_GLU = 16 * 32, I_SQ = 16 * 16;
        constexpr int NITEMS = 4 * I_IN + I_OUT + 2 * I_GLU + 6 * I_SQ;
        for (int it = gw; it < NITEMS; it += NGW) {
            int r = it;
            if (r < 4 * I_IN) { const int l = r / I_IN; if (l > 0 && (r % I_IN) < 512) continue;     transpose_item(ap->in[5] + (size_t)l * D * 2 * DFF, D, 2 * DFF, WIN + (size_t)l * 2 * DFF * D, DFF, scr, r % I_IN, lane); continue; } r -= 4 * I_IN;
            if (r < I_OUT) { transpose_item(ap->in[6], DFF, D, WOUT, 0, scr, r, lane); continue; } r -= I_OUT;
            if (r < 2 * I_GLU) { const int l = r / I_GLU; transpose_item(ap->in[15] + (size_t)l * D * 2 * D, D, 2 * D, WGLU + (size_t)l * 2 * D * D, D, scr, r % I_GLU, lane); continue; } r -= 2 * I_GLU;
            const int wsel = r / I_SQ; r %= I_SQ;
            const float* src = wsel == 0 ? ap->in[18] : wsel == 1 ? ap->in[19] : wsel < 4 ? ap->in[20] + (size_t)(wsel - 2) * D * D : ap->in[21] + (size_t)(wsel - 4) * D * D;
            bf16_t* dst = wsel == 0 ? WK : wsel == 1 ? WV : wsel < 4 ? WQ + (size_t)(wsel - 2) * D * D : WO + (size_t)(wsel - 4) * D * D;
            transpose_item(src, D, D, dst, 0, scr, r, lane);
        }
        rowpass(gw, NGW, lane, x, nullptr, 0, 0, nullptr, nullptr, AEXT, ap->in[1], 1, nullptr, nullptr);
    PH_END_CG

#if EXTRA_SYNCS
    for (int i_ = 0; i_ < EXTRA_SYNCS; ++i_) xcd_barrier(xbar);
#endif
    for (int l = 0; l < 4; ++l) {
        if (l < 2) {
            PH_BEGIN
                { pg8::Gemm g{AEXT, W1T + (size_t)l * NG * 128 * 256, NCH, 256, 256, AK, 256, NG, (unsigned)NCH * AK, 128u * 256u};
                  pg8::EpiS5State E{}; pg8::gemm_phase(lds, g, E, G, c, tid); }
                __syncthreads();
                s5_scan(lds, Sb, SC, AEXT, (float*)(ws + WS_XCH + 3 * MiB), (unsigned*)(ws + WS_CNT2), l, G, c, tid);
                { pg8::Gemm g{AEXT, BT3 + (size_t)l * NG * 256 * AK, NCH, 256, AK, AK, AK, NG, (unsigned)NCH * AK, 256u * AK};
                  pg8::EpiS5Out E{AEXT, ap->in[14] + (size_t)l * NG * 16, Yb}; pg8::gemm_phase(lds, g, E, G, c, tid); }
            PH_END
            DUPFOR(2) PH_BEGIN
#if DIAG == 1
                if (l == 0) { if (c == 0) { S5In in{ap->in[7], ap->in[8], ap->in[9], ap->in[10], ap->in[11], ap->in[12], ap->in[13]}; diag_s5(in, ap->in[14], AEXT, Yb, (float*)ws, tid); if (tid == 0) out[0] = (digit_of(((float*)ws)[0]) + 1.f) * 10000.f; } return; }
#endif
                pg8::Gemm g{Yb, WGLU + (size_t)l * 2 * D * D, L, 2 * D, D, D, D, 1, 0, 0};
                pg8::EpiGLU E{MIX, D, ap->in[16] + (size_t)l * 2 * D, D}; pg8::gemm_phase(lds, g, E, G, c, tid);
            PH_END
        } else {
            const int b = l - 2;
            DUPFOR(2) PH_BEGIN
                if (l == 2) {
                    { pg8::Gemm g{HK, WK, L, D, D, D, D, 1, 0, 0}; pg8::EpiPlain E{KB, D, 1.0f}; pg8::gemm_phase(lds, g, E, G, c, tid); }
                    { pg8::Gemm g{WV, HK, D, L, D, D, D, 1, 0, 0}; pg8::EpiPlain E{VT, L, 1.0f}; pg8::gemm_phase(lds, g, E, G, c, tid); }
                }
                { pg8::Gemm g{MIX, WQ + (size_t)b * D * D, L, D, D, D, D, 1, 0, 0}; pg8::EpiPlain E{Qb, D, 0.18033688011112042f  }; pg8::gemm_phase(lds, g, E, G, c, tid); }
#if DIAG == 2
                grid.sync(); __threadfence(); grid.sync();
#endif
            PH_END
            DUPFOR(3) PH_BEGIN
                attn_phase(lds, Qb, KB, VT, Ob, G, c, tid);
            PH_END
            DUPFOR(2) PH_BEGIN
#if DIAG == 2
                if (l == 2) { if (c == 1) { diag_attn(Qb, KB, VT, Ob, (float*)ws, tid); __syncthreads(); if (tid == 0) { const float* res = (const float*)ws; int lo4 = 0, hi4 = 0; for (int i = 0; i < 4; ++i) { if (res[1 + i] > 0.1f) lo4 |= 1 << i; if (res[5 + i] > 0.1f) hi4 |= 1 << i; } float V = (10.f + (float)lo4) * 1000.f; for (int i = 0; i < hi4; ++i) V *= 10.f; out[0] = V; } } return; }
#endif
                pg8::Gemm g{Ob, WO + (size_t)b * D * D, L, D, D, D, D, 1, 0, 0};
                bf16_t* hslot = (bf16_t*)out + D;
                pg8::EpiResNorm E{hslot, 2 * D, l == 3 ? KB : hslot, l == 3 ? D : 2 * D, nullptr, ap->in[2] + l * D, MIX, ap->in[3] + l * D, 0, nullptr, nullptr, (float*)(ws + WS_XCH), (unsigned*)(ws + WS_CNT), b};
                pg8::gemm_phase(lds, g, E, G, c, tid);
            PH_END
        }
        if (l < 2) {
        DUPFOR(4) PH_BEGIN
            rowpass(gw, NGW, lane, x, out, l == 0 ? 0 : 1, 1, MIX, ap->in[2] + l * D, MIX, ap->in[3] + l * D, 0, nullptr, nullptr);
        PH_END
        }
        DUPFOR(5) PH_BEGIN
            pg8::Gemm g{MIX, WIN + (size_t)l * 2 * DFF * D, L, 2 * DFF, D, D, D, 1, 0, 0};
            pg8::EpiSwiGLU E{ACT, DFF}; pg8::gemm_phase(lds, g, E, G, c, tid);
            if (l < 3 && c >= G / 2) {
                LAS unsigned short* scr = (LAS unsigned short*)(lds + wave * 16384);
                constexpr int I_OUT = 44 * 16;
                const int hw = (c - G / 2) * 8 + wave, NHW = (G - G / 2) * 8, ln = l + 1;
                for (int it = hw; it < I_OUT; it += NHW) transpose_item(ap->in[6] + (size_t)ln * DFF * D, DFF, D, WOUT + (size_t)ln * D * DFF, 0, scr, it, lane);
                for (int it = hw; it < 512; it += NHW) transpose_item(ap->in[5] + (size_t)ln * D * 2 * DFF, D, 2 * DFF, WIN + (size_t)ln * 2 * DFF * D, DFF, scr, it, lane);
            }
        PH_END
        PH_BEGIN
            pg8::Gemm g{ACT, WOUT + (size_t)l * D * DFF, L, D, DFF, DFF, DFF, 1, 0, 0};
            bf16_t* hslot = (bf16_t*)out + D;
            const bf16_t* hin = l == 3 ? KB : hslot; const int hin_pitch = l == 3 ? D : 2 * D;
            bf16_t* o1 = l == 0 ? AEXT : l == 3 ? nullptr : MIX; const float* gg1 = ap->in[1] + (l < 3 ? l + 1 : 0) * D;
            pg8::EpiResNorm E{hin, hin_pitch, hslot, 2 * D, l == 3 ? out : nullptr, ap->in[4] + l * D, o1, gg1, l == 0 ? 1 : 0, l == 1 ? HK : nullptr, ap->in[17], (float*)(ws + WS_XCH), (unsigned*)(ws + WS_CNT), 2 + l};
            pg8::gemm_phase(lds, g, E, G, c, tid);
        PH_END_LAST(DIAG != 3 && l == 3)
    }
#if DIAG == 3
    grid.sync();
    if (c0 == 0 && threadIdx.x == 0) a.out[0] = (float)tacc * 10.0f;
#endif
#undef PH_BEGIN
#undef PH_END
#undef PH_END_CG
#undef PH_END_LAST
}
constexpr int N_PHASES = 1 + 2 * 8 + 2 * 7;

extern "C" void kernel_launch(void* const* d_in, const int* in_sizes, int n_in, void* d_out, int out_size, void* d_ws, size_t ws_size, hipStream_t stream) {
    static int grid = 0;
    if (grid == 0) {
        if (n_in != 22 || in_sizes[0] != L * D || out_size != L * D || ws_size < WS_END) { fprintf(stderr, "kernel_launch: unexpected shapes (n_in %d in0 %d out %d ws %zu)\n", n_in, n_in > 0 ? in_sizes[0] : -1, out_size, ws_size); grid = -1; return; }
        int dev = 0, cus = 0, per_cu = 0;
        hipGetDevice(&dev); hipDeviceGetAttribute(&cus, hipDeviceAttributeMultiprocessorCount, dev);
        if (hipFuncSetAttribute((const void*)mk_fwd, hipFuncAttributeMaxDynamicSharedMemorySize, LDS_BYTES) != hipSuccess) { fprintf(stderr, "kernel_launch: hipFuncSetAttribute failed\n"); grid = -1; return; }
        if (hipOccupancyMaxActiveBlocksPerMultiprocessor(&per_cu, (const void*)mk_fwd, 512, LDS_BYTES) != hipSuccess || per_cu < 1) { fprintf(stderr, "kernel_launch: occupancy query says %d blocks/CU\n", per_cu); grid = -1; return; }
        if (cus != 256) { fprintf(stderr, "kernel_launch: built for a 256-CU device (one 256x256 unit per workgroup in the fused-epilogue phases); found %d CUs, nothing launched\n", cus); grid = -1; return; }
        grid = cus;
    }
    if (grid < 0) return;
    if (hipMemsetAsync(d_ws, 0, CTL_ZERO_BYTES, stream) != hipSuccess) { fprintf(stderr, "kernel_launch: memset failed\n"); return; }
    Args a{};
    for (int i = 0; i < 22; ++i) a.in[i] = (const float*)d_in[i];
    a.out = (float*)d_out; a.ws = (unsigned char*)d_ws;
#if MK_ONE_LAUNCH
    a.ph_lo = 0; a.ph_hi = N_PHASES;
    void* args[] = {&a};
    hipError_t e = hipLaunchCooperativeKernel((const void*)mk_fwd, dim3(grid), dim3(512), args, LDS_BYTES, stream);
    if (e != hipSuccess) fprintf(stderr, "cooperative launch failed: %s (grid %d)\n", hipGetErrorString(e), grid);
#else
    for (int p = 0; p < N_PHASES; ++p) { a.ph_lo = p; a.ph_hi = p + 1; hipLaunchKernelGGL(mk_fwd, dim3(grid), dim3(512), LDS_BYTES, stream, a); }
#endif
}
```
